# Optimizing an MI355X kernel written in HIP

```python
import math
import jax, jax.numpy as jnp
from jax import lax
import numpy as np

D_MODEL = 1024
BATCH = 4
SEQ = 8192
DEPTH = 2

HEAD_DIM = 64
D_MIX = D_MODEL
D_CONV = D_MIX // 4
D_SSM = D_MIX // 4
D_SB = D_MIX // 4
D_NSA = D_MIX - D_CONV - D_SSM - D_SB

CONV_WIDTH = 3

SSM_GROUP = 16
SSM_N_GROUPS = D_SSM // SSM_GROUP
SSM_STATE = 64
SSM_DT_MIN = 1e-3
SSM_DT_MAX = 1e-1
SSM_MAX_RE = -1e-4

SB_HEADS = D_SB // HEAD_DIM

NSA_HEADS = D_NSA // HEAD_DIM
NSA_KV_HEADS = 2
NSA_HPG = NSA_HEADS // NSA_KV_HEADS
CMP_LEN = 32
CMP_STRIDE = 16
CMP_HIDDEN = 4 * HEAD_DIM
SLC_BLOCK = 64
SLC_TOPK = 16
WINDOW = 512
FORCE_BONUS = 1e4
NEG_INF = -1e30

Q_BLOCK = 128
ROPE_THETA = 10000.0
RMS_EPS = 1e-6

D_FF = 7 * D_MODEL // 2
N_EXPERTS = 8
TOP_K = 2
N_DENSE = (DEPTH + 1) // 2
N_MOE = DEPTH // 2

N_CONV_COLS = 3 * D_CONV
N_SSM_COLS = D_SSM
N_SB_COLS = 3 * D_SB
N_NSA_KV_COLS = 6 * NSA_KV_HEADS * HEAD_DIM
N_NSA_COLS = D_NSA + N_NSA_KV_COLS + 3 * NSA_HEADS
N_IN = N_CONV_COLS + N_SSM_COLS + N_SB_COLS + N_NSA_COLS

kernel_name = 'hybrid_parallel_mixer_block'


def rms_norm(x, g):
    xf = x.astype(jnp.float32)
    y = xf * lax.rsqrt(jnp.mean(xf * xf, axis=-1, keepdims=True) + RMS_EPS)
    return (y * g.astype(jnp.float32)).astype(x.dtype)


def rope(x, pos):
    half = HEAD_DIM // 2
    inv_freq = jnp.power(jnp.float32(ROPE_THETA), -jnp.arange(half, dtype=jnp.float32) / half)
    ang = pos.astype(jnp.float32)[..., None] * inv_freq
    cos = jnp.cos(ang)[:, :, None, :]
    sin = jnp.sin(ang)[:, :, None, :]
    xf = x.astype(jnp.float32)
    x1, x2 = xf[..., :half], xf[..., half:]
    return jnp.concatenate([x1 * cos - x2 * sin, x2 * cos + x1 * sin], axis=-1).astype(x.dtype)


def masked_softmax(scores, mask):
    p = jax.nn.softmax(jnp.where(mask, scores, NEG_INF), axis=-1)
    return jnp.where(mask, p, 0.0)


def to_blocks(a):
    return a.reshape(a.shape[0], a.shape[1] // Q_BLOCK, Q_BLOCK, *a.shape[2:]).swapaxes(0, 1)


def from_blocks(a):
    a = a.swapaxes(0, 1)
    return a.reshape(a.shape[0], a.shape[1] * a.shape[2], -1)


def short_conv_mixer(z, conv_w):
    gate_b, gate_c, u = jnp.split(z, 3, axis=-1)
    v = gate_c * u
    y = lax.conv_general_dilated(
        v, conv_w.astype(v.dtype)[:, None, :], window_strides=(1,),
        padding=[(CONV_WIDTH - 1, 0)], dimension_numbers=('NWC', 'WIO', 'NWC'),
        feature_group_count=D_CONV)
    return gate_b * y


def s5_mixer(u, lam_re, lam_im, b_re, b_im, c_re, c_im, d_skip, log_dt, w_glu):
    f32 = jnp.float32
    Bsz, T, _ = u.shape
    uf = u.astype(f32).reshape(Bsz, T, SSM_N_GROUPS, SSM_GROUP)
    lam = lax.complex(jnp.minimum(lam_re.astype(f32), SSM_MAX_RE), lam_im.astype(f32))
    dt = jnp.exp(log_dt.astype(f32))[:, None]
    lam_bar = jnp.exp(lam * dt)
    b_bar = ((lam_bar - 1.0) / lam)[..., None] * lax.complex(b_re.astype(f32), b_im.astype(f32))
    bu = jnp.einsum('gpc,btgc->btgp', b_bar, uf)
    a = jnp.broadcast_to(lam_bar, bu.shape)

    def combine(left, right):
        a_l, b_l = left
        a_r, b_r = right
        return a_r * a_l, a_r * b_l + b_r

    _, hs = lax.associative_scan(combine, (a, bu), axis=1)
    cmat = lax.complex(c_re.astype(f32), c_im.astype(f32))
    y = jnp.einsum('gcp,btgp->btgc', cmat, hs).real + d_skip.astype(f32).reshape(SSM_N_GROUPS, SSM_GROUP) * uf
    g = jax.nn.gelu(y.reshape(Bsz, T, D_SSM))
    out = g * jax.nn.sigmoid(g @ w_glu.astype(f32))
    return out.astype(u.dtype)


def stick_breaking_attention(q, k, v):
    f32 = jnp.float32
    Bsz, T, H, dh = q.shape
    scale = dh ** -0.5
    kf = k.astype(f32)
    vf = v.astype(f32)
    key_pos = jnp.arange(T)

    def block(args):
        q_blk, start = args
        z = jnp.einsum('bqhd,bshd->bhqs', q_blk.astype(f32), kf) * scale
        t = start + jnp.arange(Q_BLOCK)
        past = key_pos[None, :] < t[:, None]
        log_beta = jax.nn.log_sigmoid(z)
        log_keep = jnp.where(past, log_beta - z, 0.0)
        log_w = log_beta + lax.cumsum(log_keep, axis=3, reverse=True) - log_keep
        w = jnp.where(past, jnp.exp(log_w), 0.0)
        return jnp.einsum('bhqs,bshd->bqhd', w, vf)

    starts = jnp.arange(T // Q_BLOCK) * Q_BLOCK
    out = lax.map(block, (to_blocks(q), starts))
    return from_blocks(out).astype(q.dtype)


def compress_tokens(x, pos_emb, w1, w2):
    Bsz, T, G, dh = x.shape
    r = CMP_LEN // CMP_STRIDE
    nc = T // CMP_STRIDE - r + 1
    chunks = x.reshape(Bsz, T // CMP_STRIDE, CMP_STRIDE, G, dh)
    win = jnp.concatenate([chunks[:, j:j + nc] for j in range(r)], axis=2)
    win = win + pos_emb[:, None, :]
    win = win.transpose(0, 1, 3, 2, 4).reshape(Bsz, nc, G, CMP_LEN * dh)
    return jax.nn.silu(win @ w1) @ w2


def nsa_mixer(q, kv, gate_logits, positions, q_norm_g, k_norm_g, pos_k, pos_v, k_w1, k_w2, v_w1, v_w2):
    f32 = jnp.float32
    Bsz, T, _ = q.shape
    G, HPG, dh = NSA_KV_HEADS, NSA_HPG, HEAD_DIM
    scale = dh ** -0.5
    qh = rope(rms_norm(q.reshape(Bsz, T, NSA_HEADS, dh), q_norm_g), positions)
    qh = qh.astype(f32).reshape(Bsz, T, G, HPG, dh)
    k_cmp, v_cmp, k_slc, v_slc, k_win, v_win = jnp.moveaxis(kv.reshape(Bsz, T, 6, G, dh), 2, 0)

    nc = T // CMP_STRIDE - CMP_LEN // CMP_STRIDE + 1
    cmp_end = jnp.arange(nc) * CMP_STRIDE + CMP_LEN - 1
    kc = rope(rms_norm(compress_tokens(k_cmp, pos_k, k_w1, k_w2), k_norm_g), positions[:, cmp_end]).astype(f32)
    vc = compress_tokens(v_cmp, pos_v, v_w1, v_w2).astype(f32)

    ns = T // SLC_BLOCK
    top_n = min(SLC_TOPK, ns)
    ks = rope(rms_norm(k_slc, k_norm_g), positions).astype(f32)
    ks = ks.reshape(Bsz, ns, SLC_BLOCK, G, dh).transpose(0, 3, 1, 2, 4)
    vs = v_slc.astype(f32).reshape(Bsz, ns, SLC_BLOCK, G, dh).transpose(0, 3, 1, 2, 4)
    cmp_start = jnp.arange(nc) * CMP_STRIDE
    slc_start = jnp.arange(ns) * SLC_BLOCK
    overlap = ((cmp_start[:, None] < slc_start[None, :] + SLC_BLOCK)
               & (cmp_start[:, None] + CMP_LEN > slc_start[None, :])).astype(f32)
    blk_ids = jnp.arange(ns)
    b_ix = jnp.arange(Bsz)[:, None, None, None]
    g_ix = jnp.arange(G)[None, None, :, None]

    pad = ((0, 0), (WINDOW, 0), (0, 0), (0, 0))
    kw = jnp.pad(rope(rms_norm(k_win, k_norm_g), positions).astype(f32), pad)
    vw = jnp.pad(v_win.astype(f32), pad)

    gates = jax.nn.sigmoid(gate_logits.astype(f32)).reshape(Bsz, T, G, HPG, 3)

    def block(args):
        q_blk, g_blk, start = args
        t = start + jnp.arange(Q_BLOCK)
        m_c = (cmp_end[None, :] <= t[:, None])[None, :, None, None, :]
        p_c = masked_softmax(jnp.einsum('bqghd,bngd->bqghn', q_blk, kc) * scale, m_c)
        o_c = jnp.einsum('bqghn,bngd->bqghd', p_c, vc)
        imp = jnp.einsum('bqghn,ns->bqgs', p_c, overlap)
        cur = (t // SLC_BLOCK)[:, None]
        forced = (blk_ids[None, :] == 0) | (blk_ids[None, :] == cur) | (blk_ids[None, :] == cur - 1)
        causal = blk_ids[None, :] <= cur
        imp = jnp.where(causal[None, :, None, :], imp + FORCE_BONUS * forced[None, :, None, :], NEG_INF)
        _, idx = lax.top_k(imp, top_n)
        k_sel = ks[b_ix, g_ix, idx]
        v_sel = vs[b_ix, g_ix, idx].reshape(Bsz, Q_BLOCK, G, top_n * SLC_BLOCK, dh)
        key_pos = (idx[..., None] * SLC_BLOCK + jnp.arange(SLC_BLOCK)).reshape(Bsz, Q_BLOCK, G, 1, top_n * SLC_BLOCK)
        m_s = key_pos <= t[None, :, None, None, None]
        s_s = jnp.einsum('bqghd,bqgksd->bqghks', q_blk, k_sel).reshape(Bsz, Q_BLOCK, G, HPG, top_n * SLC_BLOCK) * scale
        o_s = jnp.einsum('bqghm,bqgmd->bqghd', masked_softmax(s_s, m_s), v_sel)
        k_w = lax.dynamic_slice_in_dim(kw, start, WINDOW + Q_BLOCK, axis=1)
        v_w = lax.dynamic_slice_in_dim(vw, start, WINDOW + Q_BLOCK, axis=1)
        wpos = start - WINDOW + jnp.arange(WINDOW + Q_BLOCK)
        m_w = ((wpos[None, :] <= t[:, None]) & (wpos[None, :] > t[:, None] - WINDOW)
               & (wpos[None, :] >= 0))[None, :, None, None, :]
        p_w = masked_softmax(jnp.einsum('bqghd,bsgd->bqghs', q_blk, k_w) * scale, m_w)
        o_w = jnp.einsum('bqghs,bsgd->bqghd', p_w, v_w)
        return g_blk[..., 0:1] * o_c + g_blk[..., 1:2] * o_s + g_blk[..., 2:3] * o_w

    starts = jnp.arange(T // Q_BLOCK) * Q_BLOCK
    out = lax.map(block, (to_blocks(qh), to_blocks(gates), starts))
    return from_blocks(out).astype(q.dtype)


def hybrid_token_mixing(a, positions, w_in, w_out, conv_w, lam_re, lam_im, b_re, b_im, c_re, c_im, d_skip,
                        log_dt, w_glu, q_norm_g, k_norm_g, pos_k, pos_v, k_w1, k_w2, v_w1, v_w2):
    Bsz, T, _ = a.shape
    z = a @ w_in
    o1 = N_CONV_COLS
    o2 = o1 + N_SSM_COLS
    o3 = o2 + N_SB_COLS
    o4 = o3 + D_NSA
    o5 = o4 + N_NSA_KV_COLS
    y_conv = short_conv_mixer(z[..., :o1], conv_w)
    y_ssm = s5_mixer(z[..., o1:o2], lam_re, lam_im, b_re, b_im, c_re, c_im, d_skip, log_dt, w_glu)
    sb = z[..., o2:o3].reshape(Bsz, T, 3, SB_HEADS, HEAD_DIM)
    y_sb = stick_breaking_attention(sb[:, :, 0], sb[:, :, 1], sb[:, :, 2])
    y_nsa = nsa_mixer(z[..., o3:o4], z[..., o4:o5], z[..., o5:], positions, q_norm_g, k_norm_g,
                      pos_k, pos_v, k_w1, k_w2, v_w1, v_w2)
    y = jnp.concatenate([y_conv, y_ssm, y_sb, y_nsa], axis=-1).astype(a.dtype)
    return y @ w_out


def swiglu(h, w_gate, w_up, w_down):
    return (jax.nn.silu(h @ w_gate) * (h @ w_up)) @ w_down


def moe_swiglu(h, router_w, w_gate, w_up, w_down):
    logits = (h @ router_w).astype(jnp.float32)
    top_val, top_idx = lax.top_k(logits, TOP_K)
    top_w = jax.nn.softmax(top_val, axis=-1)
    gate = jnp.sum(jax.nn.one_hot(top_idx, N_EXPERTS, dtype=jnp.float32) * top_w[..., None], axis=-2)
    gate = gate.astype(h.dtype)
    out = jnp.zeros_like(h)
    for e in range(N_EXPERTS):
        out = out + gate[..., e:e + 1] * swiglu(h, w_gate[e], w_up[e], w_down[e])
    return out


def setup_inputs(seed: int = 0) -> dict:
    key = jax.random.key(seed)
    keys = iter(jax.random.split(key, 64))

    def nrm(shape, scale):
        return jax.random.normal(next(keys), shape, jnp.float32) * scale

    D, F, E = D_MODEL, D_FF, N_EXPERTS
    G, P, HC = SSM_N_GROUPS, SSM_STATE, SSM_GROUP
    x = nrm((BATCH, SEQ, D), 1.0)
    c = nrm((BATCH, D), 1.0)
    positions = (jnp.arange(SEQ, dtype=jnp.int32)[None, :]
                 + jax.random.randint(next(keys), (BATCH, 1), 0, 1024, dtype=jnp.int32))
    return {
        'x': x,
        'c': c,
        'positions': positions,
        'ada_w': nrm((DEPTH, D, 6 * D), 0.5 * D ** -0.5),
        'ada_b': nrm((DEPTH, 6 * D), 0.01),
        'norm_mix_g': 1.0 + nrm((DEPTH, D), 0.02),
        'norm_ffn_g': 1.0 + nrm((DEPTH, D), 0.02),
        'w_in': nrm((DEPTH, D, N_IN), D ** -0.5),
        'w_out': nrm((DEPTH, D_MIX, D), D_MIX ** -0.5),
        'conv_w': nrm((DEPTH, CONV_WIDTH, D_CONV), CONV_WIDTH ** -0.5),
        'ssm_lam_re': -0.5 + nrm((DEPTH, G, P), 0.01),
        'ssm_lam_im': math.pi * jnp.arange(P, dtype=jnp.float32) + nrm((DEPTH, G, P), 0.01),
        'ssm_b_re': nrm((DEPTH, G, P, HC), (2 * HC) ** -0.5),
        'ssm_b_im': nrm((DEPTH, G, P, HC), (2 * HC) ** -0.5),
        'ssm_c_re': nrm((DEPTH, G, HC, P), P ** -0.5),
        'ssm_c_im': nrm((DEPTH, G, HC, P), P ** -0.5),
        'ssm_d': nrm((DEPTH, D_SSM), 1.0),
        'ssm_log_dt': jax.random.uniform(next(keys), (DEPTH, G), dtype=jnp.float32,
                                         minval=math.log(SSM_DT_MIN), maxval=math.log(SSM_DT_MAX)),
        'ssm_w_glu': nrm((DEPTH, D_SSM, D_SSM), D_SSM ** -0.5),
        'nsa_q_norm_g': 1.0 + nrm((DEPTH, HEAD_DIM), 0.02),
        'nsa_k_norm_g': 1.0 + nrm((DEPTH, HEAD_DIM), 0.02),
        'cmp_pos_k': nrm((DEPTH, CMP_LEN, HEAD_DIM), 0.1),
        'cmp_pos_v': nrm((DEPTH, CMP_LEN, HEAD_DIM), 0.1),
        'cmp_k_w1': nrm((DEPTH, CMP_LEN * HEAD_DIM, CMP_HIDDEN), (CMP_LEN * HEAD_DIM) ** -0.5),
        'cmp_k_w2': nrm((DEPTH, CMP_HIDDEN, HEAD_DIM), CMP_HIDDEN ** -0.5),
        'cmp_v_w1': nrm((DEPTH, CMP_LEN * HEAD_DIM, CMP_HIDDEN), (CMP_LEN * HEAD_DIM) ** -0.5),
        'cmp_v_w2': nrm((DEPTH, CMP_HIDDEN, HEAD_DIM), CMP_HIDDEN ** -0.5),
        'ffn_w_gate': nrm((N_DENSE, D, F), D ** -0.5),
        'ffn_w_up': nrm((N_DENSE, D, F), D ** -0.5),
        'ffn_w_down': nrm((N_DENSE, F, D), F ** -0.5),
        'moe_router': nrm((N_MOE, D, E), D ** -0.5),
        'moe_w_gate': nrm((N_MOE, E, D, F), D ** -0.5),
        'moe_w_up': nrm((N_MOE, E, D, F), D ** -0.5),
        'moe_w_down': nrm((N_MOE, E, F, D), F ** -0.5),
    }


def reference(x, c, positions, ada_w, ada_b, norm_mix_g, norm_ffn_g, w_in, w_out, conv_w,
              ssm_lam_re, ssm_lam_im, ssm_b_re, ssm_b_im, ssm_c_re, ssm_c_im, ssm_d, ssm_log_dt, ssm_w_glu,
              nsa_q_norm_g, nsa_k_norm_g, cmp_pos_k, cmp_pos_v, cmp_k_w1, cmp_k_w2, cmp_v_w1, cmp_v_w2,
              ffn_w_gate, ffn_w_up, ffn_w_down, moe_router, moe_w_gate, moe_w_up, moe_w_down):
    h = x
    cond = jax.nn.silu(c)
    for layer in range(DEPTH):
        mod = (cond @ ada_w[layer] + ada_b[layer])[:, None, :]
        shift_mix, scale_mix, gate_mix, shift_ffn, scale_ffn, gate_ffn = jnp.split(mod, 6, axis=-1)
        a = rms_norm(h, norm_mix_g[layer]) * (1.0 + scale_mix) + shift_mix
        mix = hybrid_token_mixing(
            a, positions, w_in[layer], w_out[layer], conv_w[layer],
            ssm_lam_re[layer], ssm_lam_im[layer], ssm_b_re[layer], ssm_b_im[layer],
            ssm_c_re[layer], ssm_c_im[layer], ssm_d[layer], ssm_log_dt[layer], ssm_w_glu[layer],
            nsa_q_norm_g[layer], nsa_k_norm_g[layer], cmp_pos_k[layer], cmp_pos_v[layer],
            cmp_k_w1[layer], cmp_k_w2[layer], cmp_v_w1[layer], cmp_v_w2[layer])
        h = h + gate_mix * mix
        a = rms_norm(h, norm_ffn_g[layer]) * (1.0 + scale_ffn) + shift_ffn
        i = layer // 2
        if layer % 2 == 0:
            f = swiglu(a, ffn_w_gate[i], ffn_w_up[i], ffn_w_down[i])
        else:
            f = moe_swiglu(a, moe_router[i], moe_w_gate[i], moe_w_up[i], moe_w_down[i])
        h = h + gate_ffn * f
    return h
```

```cpp
#define NORM_PF 1
#include <hip/hip_runtime.h>
#include <cstdio>
#include <cstdint>

#define LAS __attribute__((address_space(3)))
#define GAS __attribute__((address_space(1)))
typedef unsigned short bf16;
typedef short bf16x8 __attribute__((ext_vector_type(8)));
typedef short s16x4 __attribute__((ext_vector_type(4)));
typedef float f32x2 __attribute__((ext_vector_type(2)));
typedef float f32x4 __attribute__((ext_vector_type(4)));
typedef float f32x16 __attribute__((ext_vector_type(16)));
typedef unsigned u32x2 __attribute__((ext_vector_type(2)));
typedef unsigned u32x4 __attribute__((ext_vector_type(4)));
typedef __bf16 bf16x2_t __attribute__((ext_vector_type(2)));
typedef GAS unsigned gu32;
#define RLX_AGENT __ATOMIC_RELAXED, __HIP_MEMORY_SCOPE_AGENT
#define DI __device__ __forceinline__

constexpr int NB = 4, T = 8192, M = NB * T, D = 1024, NIN = 2828, NZ = 2816, FF = 3584, NE = 8;
constexpr int NC = 511;
constexpr int ZC_CB = 0, ZC_CC = 256, ZC_CU = 512, ZC_SSM = 768, ZC_SBQ = 1024, ZC_SBK = 1280, ZC_SBV = 1536, ZC_NQ = 1792, ZC_KV = 2048;
constexpr float RMS_EPS = 1e-6f;

DI unsigned f2bf(float f) { unsigned u = __builtin_bit_cast(unsigned, f); return (u + 0x7fffu + ((u >> 16) & 1u)) >> 16; }
DI unsigned pk2(float lo, float hi) { f32x2 v = {lo, hi}; bf16x2_t b = __builtin_convertvector(v, bf16x2_t); return __builtin_bit_cast(unsigned, b); }
DI float bf2f(unsigned b) { return __builtin_bit_cast(float, b << 16); }
DI float bflo(unsigned w) { return __builtin_bit_cast(float, w << 16); }
DI float bfhi(unsigned w) { return __builtin_bit_cast(float, w & 0xffff0000u); }
#define WR_DPP(v, ctrl) __builtin_bit_cast(float, __builtin_amdgcn_update_dpp(0, __builtin_bit_cast(int, (v)), (ctrl), 0xf, 0xf, true))
DI float wave_sum(float v) {
    v += WR_DPP(v, 0xB1); v += WR_DPP(v, 0x4E); v += WR_DPP(v, 0x141); v += WR_DPP(v, 0x140);
    const int b = __builtin_bit_cast(int, v);
    return (__builtin_bit_cast(float, __builtin_amdgcn_readlane(b, 0)) + __builtin_bit_cast(float, __builtin_amdgcn_readlane(b, 16))) + (__builtin_bit_cast(float, __builtin_amdgcn_readlane(b, 32)) + __builtin_bit_cast(float, __builtin_amdgcn_readlane(b, 48)));
}
DI float wave_max(float v) {
    v = fmaxf(v, WR_DPP(v, 0xB1)); v = fmaxf(v, WR_DPP(v, 0x4E)); v = fmaxf(v, WR_DPP(v, 0x141)); v = fmaxf(v, WR_DPP(v, 0x140));
    const int b = __builtin_bit_cast(int, v);
    return fmaxf(fmaxf(__builtin_bit_cast(float, __builtin_amdgcn_readlane(b, 0)), __builtin_bit_cast(float, __builtin_amdgcn_readlane(b, 16))), fmaxf(__builtin_bit_cast(float, __builtin_amdgcn_readlane(b, 32)), __builtin_bit_cast(float, __builtin_amdgcn_readlane(b, 48))));
}

namespace pg8 {
constexpr int BM = 256, BK = 64, HALF = 128, HTB = HALF * BK * 2, STAGE_BYTES = 8 * HTB, NXCD = 8, WGM = 8;
__host__ __device__ __forceinline__ int lds_byte(int r, int c) { const int st = (r >> 4) * 2 + (c >> 5), rr = r & 15, cc = c & 31, ob = rr * 64 + cc * 2; return st * 1024 + (ob ^ (((ob >> 9) & 1) << 5)); }
__host__ __device__ __forceinline__ void stage_rc(int b, int& R, int& C) { const int st = b / 1024, sb = b % 1024, swz = sb ^ (((sb >> 9) & 1) << 5); R = (st >> 1) * 16 + swz / 64; C = (st & 1) * 32 + (swz % 64) / 2; }
__host__ __device__ __forceinline__ int perm32(int rho) { const int n = rho >> 4, i = rho & 15; return 8 * (i >> 2) + 4 * n + (i & 3); }

struct Unit { int pm, pn, e, lt, pl, kt0, nkt, part; };
struct Gemm { const bf16* A; const bf16* Bt; int M, N, K; };

struct StaticOrder {
    int nM, nN, nwg, G, c, KT;
    __device__ void init(int M_, int N_, int K_, int G_, int c_) { nM = M_ / BM; nN = N_ / BM; nwg = nM * nN; G = G_; c = c_; KT = K_ / BK; }
    __device__ bool next(int i, Unit& u) const {
        const long L = (long)i * G + c; if (L >= nwg) return false;
        int wgid = (int)L; { const int q = nwg / NXCD, r = nwg % NXCD, xcd = wgid % NXCD, off = wgid / NXCD; wgid = (xcd < r ? xcd * (q + 1) : r * (q + 1) + (xcd - r) * q) + off; }
        const int nig = WGM * nN, gid = wgid / nig, fm = gid * WGM, gsz = (nM - fm) < WGM ? (nM - fm) : WGM;
        u.pm = fm + ((wgid % nig) % gsz); u.pn = (wgid % nig) / gsz; u.e = 0; u.lt = u.pm; u.pl = u.pn; u.kt0 = 0; u.nkt = KT; u.part = -1; return true;
    }
    __device__ __forceinline__ unsigned row_off(const Unit&, int) const { return 0u; }
};

struct MoeOrder {
    int nRT, nN, nwg, G, c, dense, K2;
    int KT, nfull, nsplit;
    const LAS int* tile_e; const LAS int* cnt; const int* list;
    __device__ bool next(int i, Unit& u) const {
        const long L = (long)i * G + c; int unit;
        if (L < nfull) { unit = (int)L; u.kt0 = 0; u.nkt = KT; u.part = -1; }
        else { const long s = L - nfull; if (s >= (long)(nwg - nfull) * nsplit) return false; unit = nfull + (int)(s / nsplit); const int sp = (int)(s % nsplit); u.nkt = KT / nsplit; u.kt0 = sp * u.nkt; u.part = (int)s; }
        decode(unit, u); return true;
    }
    __device__ void decode(int unit, Unit& u) const {
        int wgid = unit; { const int q = nwg / NXCD, r = nwg % NXCD, xcd = wgid % NXCD, off = wgid / NXCD; wgid = (xcd < r ? xcd * (q + 1) : r * (q + 1) + (xcd - r) * q) + off; }
        const int nig = WGM * nN, gid = wgid / nig, fm = gid * WGM, gsz = (nRT - fm) < WGM ? (nRT - fm) : WGM;
        u.pm = fm + ((wgid % nig) % gsz); u.pl = (wgid % nig) / gsz;
        const int te = dense ? (u.pm << 8) : __builtin_amdgcn_readfirstlane(tile_e[u.pm]); u.e = te & 255; u.lt = te >> 8; u.pn = u.e * nN + u.pl;
    }
    __device__ __forceinline__ unsigned row_off(const Unit& u, int r) const {
        const int idx = u.lt * 256 + r; int tok;
        if (dense) tok = idx; else tok = (idx < cnt[u.e]) ? list[u.e * 32768 + idx] : 0;
        return (unsigned)tok * (unsigned)K2;
    }
};

template <class Epi, class Sched, bool ALIGN_EPI, bool GATHER>
__device__ __forceinline__ void gemm_phase(LAS unsigned char* lds, const Gemm g, const Sched& S, const Epi& E) {
    int tid_l = threadIdx.x; asm volatile("" : "+v"(tid_l));
    const int tid = tid_l, wid = __builtin_amdgcn_readfirstlane(tid >> 6), lane = tid & 63, wr = wid >> 2, wc = wid & 3, fr = lane & 15, fq = lane >> 4;
    const int K = g.K;
    unsigned voffA[2], voffB[2]; int RA[2]; unsigned CA2[2];
#pragma unroll
    for (int i = 0; i < 2; ++i) { int R, C; stage_rc(tid * 16 + i * 8192, R, C); const int Rb = Epi::PERM ? ((R & ~31) + perm32(R & 31)) : R;
        voffA[i] = (unsigned)(R * K + C) * 2u; voffB[i] = (unsigned)(Rb * K + C) * 2u; RA[i] = R; CA2[i] = (unsigned)C * 2u; }
    const size_t kstep = (size_t)(BK * 2);
    const size_t hstep = (size_t)HALF * K * 2;
    const size_t tstep = 2 * hstep;
    const unsigned ldsw = (unsigned)wid * 1024u;
    const int aoff = lds_byte(wr * 64 + fr, fq * 8), boff = lds_byte(wc * 32 + fr, fq * 8);
#define PG8_SA(b, h) (((b) * 2 + (h)) * HTB)
#define PG8_SB(b, h) ((4 + (b) * 2 + (h)) * HTB)
#define PG8_STAGE(bufoff, gbase, voff) do { _Pragma("unroll") for (int _i = 0; _i < 2; ++_i) \
        __builtin_amdgcn_global_load_lds((const unsigned*)((const char*)(gbase) + (voff)[_i]), (LAS unsigned*)(lds + (bufoff) + ldsw + _i * 8192), 16, 0, 0); } while (0)
#define PG8_STAGE_A(b, h, gbase, vg) do { if constexpr (GATHER) { PG8_STAGE(PG8_SA(b, h), gbase, (vg)[h]); } else { PG8_STAGE(PG8_SA(b, h), (gbase) + (h) * hstep, voffA); } } while (0)
#define PG8_LDA(dst, b, h) do { _Pragma("unroll") for (int m = 0; m < 4; ++m) _Pragma("unroll") for (int k = 0; k < 2; ++k) dst[m][k] = *(const LAS bf16x8*)(lds + PG8_SA(b, h) + aoff + m * 2048 + k * 1024); } while (0)
#define PG8_LDB(dst, b, h) do { _Pragma("unroll") for (int n = 0; n < 2; ++n) _Pragma("unroll") for (int k = 0; k < 2; ++k) dst[n][k] = *(const LAS bf16x8*)(lds + PG8_SB(b, h) + boff + n * 2048 + k * 1024); } while (0)
#define PG8_MMA(ai, bj, At, Bt) do { __builtin_amdgcn_s_setprio(1); _Pragma("unroll") for (int m = 0; m < 4; ++m) _Pragma("unroll") for (int n = 0; n < 2; ++n) _Pragma("unroll") for (int k = 0; k < 2; ++k) \
        acc[ai][bj][m][n] = __builtin_amdgcn_mfma_f32_16x16x32_bf16(Bt[n][k], At[m][k], acc[ai][bj][m][n], 0, 0, 0); __builtin_amdgcn_s_setprio(0); } while (0)
#define PG8_WAIT_V(n) asm volatile("s_waitcnt vmcnt(" #n ")" ::: "memory")
#define PG8_WAIT_L(n) asm volatile("s_waitcnt lgkmcnt(" #n ")" ::: "memory")
#define PG8_BAR __builtin_amdgcn_s_barrier()
#define PG8_SCHED __builtin_amdgcn_sched_barrier(0)
    Unit cur, nxt; int ui = 0;
    if (!S.next(0, cur)) return;
    f32x4 acc[2][2][4][2];
#pragma unroll
    for (int a = 0; a < 2; ++a)
#pragma unroll
        for (int b = 0; b < 2; ++b)
#pragma unroll
            for (int m = 0; m < 4; ++m)
#pragma unroll
                for (int n = 0; n < 2; ++n) acc[a][b][m][n] = (f32x4){0.f, 0.f, 0.f, 0.f};
    bf16x8 At[4][2], B0[2][2], B1[2][2];
    unsigned vgc[2][2], vgn[2][2];
    const char* cA = (GATHER ? (const char*)g.A : (const char*)g.A + (size_t)cur.pm * tstep) + (size_t)cur.kt0 * kstep; const char* cB = (const char*)g.Bt + (size_t)cur.pn * tstep + (size_t)cur.kt0 * kstep;
    if constexpr (GATHER) {
#pragma unroll
        for (int h = 0; h < 2; ++h)
#pragma unroll
            for (int i = 0; i < 2; ++i) { vgc[h][i] = S.row_off(cur, h * HALF + RA[i]) + CA2[i]; vgn[h][i] = vgc[h][i]; }
    }
    PG8_STAGE(PG8_SB(0, 0), cB, voffB); PG8_STAGE(PG8_SB(0, 1), cB + hstep, voffB); PG8_STAGE_A(0, 0, cA, vgc); PG8_STAGE_A(0, 1, cA, vgc);
    if (wr == 1) PG8_BAR;
    PG8_WAIT_V(2); PG8_BAR;
    PG8_STAGE(PG8_SB(1, 0), cB + kstep, voffB); PG8_STAGE_A(1, 0, cA + kstep, vgc); PG8_STAGE(PG8_SB(1, 1), cB + hstep + kstep, voffB);
    PG8_WAIT_V(6); PG8_BAR;
    for (;;) {
        const bool has_next = S.next(ui + 1, nxt);
        const char* nA = has_next ? (GATHER ? (const char*)g.A : (const char*)g.A + (size_t)nxt.pm * tstep) + (size_t)nxt.kt0 * kstep : cA; const char* nB = has_next ? (const char*)g.Bt + (size_t)nxt.pn * tstep + (size_t)nxt.kt0 * kstep : cB;
        const int nt = cur.nkt;
        if constexpr (GATHER) {
            if (has_next) {
#pragma unroll
                for (int h = 0; h < 2; ++h)
#pragma unroll
                    for (int i = 0; i < 2; ++i) vgn[h][i] = S.row_off(nxt, h * HALF + RA[i]) + CA2[i];
            }
        }
        for (int t = 0; t < nt; t += 2) {
            const bool last = (t == nt - 2);
            const char* a1 = cA + (size_t)(t + 1) * kstep;
            const char* a2 = last ? nA : cA + (size_t)(t + 2) * kstep; const char* b2 = last ? nB : cB + (size_t)(t + 2) * kstep;
            const char* a3 = a2 + kstep; const char* b3 = b2 + kstep;
            unsigned vg2[2][2];
            if constexpr (GATHER) {
#pragma unroll
                for (int h = 0; h < 2; ++h)
#pragma unroll
                    for (int i = 0; i < 2; ++i) vg2[h][i] = last ? vgn[h][i] : vgc[h][i];
            }
            PG8_LDB(B0, 0, 0); PG8_LDB(B1, 0, 1); PG8_SCHED; PG8_LDA(At, 0, 0); PG8_STAGE_A(1, 1, a1, vgc);
            PG8_WAIT_V(8); PG8_WAIT_L(0); PG8_BAR; PG8_MMA(0, 0, At, B0); PG8_MMA(0, 1, At, B1); PG8_BAR; PG8_SCHED;
            PG8_LDA(At, 0, 1); PG8_STAGE(PG8_SB(0, 0), b2, voffB); PG8_STAGE(PG8_SB(0, 1), b2 + hstep, voffB); PG8_STAGE_A(0, 0, a2, vg2);
            PG8_WAIT_V(8); PG8_WAIT_L(0); PG8_BAR; PG8_MMA(1, 0, At, B0); PG8_MMA(1, 1, At, B1); PG8_BAR; PG8_SCHED;
            PG8_LDB(B0, 1, 0); PG8_LDB(B1, 1, 1); PG8_SCHED; PG8_LDA(At, 1, 0); PG8_STAGE_A(0, 1, a2, vg2);
            PG8_WAIT_V(8); PG8_WAIT_L(0); PG8_BAR; PG8_MMA(0, 0, At, B0); PG8_MMA(0, 1, At, B1); PG8_BAR; PG8_SCHED;
            PG8_LDA(At, 1, 1); PG8_STAGE(PG8_SB(1, 0), b3, voffB); PG8_STAGE(PG8_SB(1, 1), b3 + hstep, voffB); PG8_STAGE_A(1, 0, a3, vg2);
            PG8_WAIT_V(8); PG8_WAIT_L(0); PG8_BAR; PG8_MMA(1, 0, At, B0); PG8_MMA(1, 1, At, B1); PG8_BAR; PG8_SCHED;
        }
        if constexpr (ALIGN_EPI) { if (wr == 0) PG8_BAR; }
        E(acc, cur, wr, wc, fr, fq);
        if (!has_next) break;
#pragma unroll
        for (int a = 0; a < 2; ++a)
#pragma unroll
            for (int b = 0; b < 2; ++b)
#pragma unroll
                for (int m = 0; m < 4; ++m)
#pragma unroll
                    for (int n = 0; n < 2; ++n) acc[a][b][m][n] = (f32x4){0.f, 0.f, 0.f, 0.f};
        cur = nxt; cA = nA; cB = nB; ++ui;
        if constexpr (GATHER) {
#pragma unroll
            for (int h = 0; h < 2; ++h)
#pragma unroll
                for (int i = 0; i < 2; ++i) vgc[h][i] = vgn[h][i];
        }
        if constexpr (ALIGN_EPI) { if (wr == 1) PG8_BAR; }
    }
    PG8_WAIT_V(0);
    if constexpr (!ALIGN_EPI) { if (wr == 0) PG8_BAR; }
    PG8_BAR;
#undef PG8_SA
#undef PG8_SB
#undef PG8_STAGE
#undef PG8_STAGE_A
#undef PG8_LDA
#undef PG8_LDB
#undef PG8_MMA
#undef PG8_WAIT_V
#undef PG8_WAIT_L
#undef PG8_BAR
#undef PG8_SCHED
}
}
#define XB_TMO      128
#define XB_XCNT(j)  (256  + 64 * (j))
#define XB_XSUB(j)  (1280 + 64 * (j))
#define XB_XGEN(j)  (2304 + 64 * (j))
#define XB_TOP      3328
#define XB_TOPGEN   3392
#define XCD_BAR_WORDS 3456
#define XB_SPIN_CAP (1u << 18)

__device__ __forceinline__ unsigned xb_ld(unsigned* p)              { return __hip_atomic_load(p, __ATOMIC_RELAXED, __HIP_MEMORY_SCOPE_AGENT); }
__device__ __forceinline__ unsigned xb_add(unsigned* p, unsigned v) { return __hip_atomic_fetch_add(p, v, __ATOMIC_RELAXED, __HIP_MEMORY_SCOPE_AGENT); }
__device__ __forceinline__ unsigned xb_xcc_id() { return (unsigned)__builtin_amdgcn_s_getreg((3 << 11) | 20) & 0xFu; }
#define XB_SPIN(cond, bar) do { unsigned _sp = 0; while (cond) { __builtin_amdgcn_s_sleep(1); \
    if ((++_sp & 255u) == 0u) { if (xb_ld(&(bar)[XB_TMO])) break; if (_sp > XB_SPIN_CAP) { atomicAdd(&(bar)[XB_TMO], 1u); break; } } } } while (0)

struct XcdBarrier {
    unsigned* bar; unsigned x;
    volatile LAS unsigned* st;
};

__device__ __forceinline__ XcdBarrier xcd_barrier_post(unsigned* bar, volatile LAS unsigned* st) {
    XcdBarrier b; b.bar = bar; b.x = xb_xcc_id(); b.st = st;
    if (threadIdx.x == 0) (void)xb_add(&bar[XB_XCNT(b.x)], 1u);
    return b;
}
__device__ __forceinline__ void xcd_barrier_complete(unsigned* bar, unsigned x, unsigned& nloc, unsigned& nx) {
    const unsigned G = gridDim.x * gridDim.y * gridDim.z;
    unsigned sum, cnt, mine, sp = 0u;
    for (;;) {
        sum = 0u; cnt = 0u; mine = 0u;
#pragma unroll
        for (unsigned j = 0; j < 16; ++j) { const unsigned c = xb_ld(&bar[XB_XCNT(j)]); sum += c; cnt += (c > 0u) ? 1u : 0u; mine = (j == x) ? c : mine; }
        if (sum == G) break;
        __builtin_amdgcn_s_sleep(1);
        if ((++sp & 255u) == 0u) { if (xb_ld(&bar[XB_TMO])) break; if (sp > XB_SPIN_CAP) { atomicAdd(&bar[XB_TMO], 1u); break; } }
    }
    nloc = mine > 0u ? mine : 1u; nx = cnt > 0u ? cnt : 1u;
}

__device__ __forceinline__ void xcd_barrier(const XcdBarrier& b) {
    asm volatile("s_waitcnt vmcnt(0)" ::: "memory");
    __syncthreads();
    if (threadIdx.x == 0) {
        unsigned* bar = b.bar;
        __builtin_amdgcn_s_waitcnt(0);
        unsigned nloc = b.st[0], nx = b.st[1];
        if (nloc == 0u) { xcd_barrier_complete(bar, b.x, nloc, nx); b.st[0] = nloc; b.st[1] = nx; }
        const unsigned old = xb_add(&bar[XB_XSUB(b.x)], 1u);
        const unsigned gen = old / nloc;
        if (old + 1u == (gen + 1u) * nloc) {
            __builtin_amdgcn_fence(__ATOMIC_RELEASE, "agent");
            asm volatile("s_waitcnt vmcnt(0)" ::: "memory");
            const unsigned og = xb_add(&bar[XB_TOP], 1u);
            const unsigned tg = og / nx;
            if (og + 1u == (tg + 1u) * nx) xb_add(&bar[XB_TOPGEN], 1u);
            else XB_SPIN(xb_ld(&bar[XB_TOPGEN]) == tg, bar);
            __builtin_amdgcn_fence(__ATOMIC_ACQUIRE, "agent");
            xb_add(&bar[XB_XGEN(b.x)], 1u);
            asm volatile("s_waitcnt vmcnt(0)" ::: "memory");
        } else {
            XB_SPIN(xb_ld(&bar[XB_XGEN(b.x)]) == gen, bar);
            __builtin_amdgcn_fence(__ATOMIC_ACQUIRE, "agent");
            asm volatile("s_waitcnt vmcnt(0)" ::: "memory");
        }
    }
    __syncthreads();
}

constexpr size_t MiB = 1u << 20;
constexpr size_t WS_CTL = 0, CTL_ZERO_BYTES = 1 * MiB;
constexpr size_t WS_MOD = 1 * MiB;
constexpr size_t WS_CBIAS = WS_MOD + 256 * 1024;
constexpr size_t WS_GL = 2 * MiB;
constexpr size_t WS_RTW = 4 * MiB;
constexpr size_t WS_LIST = 5 * MiB;
constexpr size_t WS_S5E = 7 * MiB;
constexpr size_t WS_S5C = 12 * MiB;
constexpr size_t WS_KC = 11 * MiB;
constexpr size_t WS_VCT = WS_KC + 512 * 1024;
constexpr size_t WS_WIN = 16 * MiB;
constexpr size_t WS_WOUT = 27 * MiB;
constexpr size_t WS_WGUD = 31 * MiB;
constexpr size_t WS_WDD = 45 * MiB;
constexpr size_t WS_WGUM = 52 * MiB;
constexpr size_t WS_WDM = 164 * MiB;
constexpr size_t WS_CW1 = 220 * MiB;
constexpr size_t WS_CW2 = 224 * MiB;
constexpr size_t WS_WGLU = WS_CW2 + 512 * 1024;
constexpr size_t WS_H16 = 226 * MiB;
constexpr size_t OB_A = 0, OB_KFSB = 0 * MiB, OB_VFSB = 16 * MiB, OB_KFSLC = 32 * MiB, OB_VFSLC = 40 * MiB, OB_KFWIN = 48 * MiB, OB_VFWIN = 56 * MiB;
constexpr size_t WS_Z = 290 * MiB;
constexpr size_t WS_Y = 466 * MiB;
constexpr size_t WS_HID = 290 * MiB;
constexpr size_t WS_PART = 530 * MiB;
constexpr size_t WS_END = 586 * MiB;
static_assert(WS_HID + (size_t)34816 * FF * 2 <= WS_PART && WS_PART + (size_t)224 * 65536 * 4 <= WS_END && WS_Z + (size_t)M * NZ * 2 <= WS_Y && WS_Y + (size_t)M * D * 2 <= WS_END, "ws map");
static_assert(WS_WDM + (size_t)8 * 1024 * FF * 2 <= WS_CW1 && WS_WGUM + (size_t)8 * 7168 * 1024 * 2 <= WS_WDM && WS_WIN + (size_t)2 * NZ * D * 2 <= WS_WOUT, "ws map 2");
constexpr int CW_BAR = 4096, CW_CNT = 8192  , CW_Q = 12288  , CW_S5F = 13312  ;

constexpr int RING_BYTES = 131072, NSA_STG_OFF = RING_BYTES  , LDSCTL_OFF = RING_BYTES + 20480, LDS_BYTES = LDSCTL_OFF + 4096;
constexpr int LC_MISC = 0, LC_BAR = 8, LC_CNT = 16, LC_TILE = 32, LC_BASE = 200  , LC_LCNT = 216  , LC_UNI = 232  , LC_BLIST = 256  , LC_ITEMS = 384  ;

#ifndef NORM_PF
#define NORM_PF 4
#endif
#define LDS_WAIT() asm volatile("s_waitcnt lgkmcnt(0)" ::: "memory")
#define VM_WAIT() asm volatile("s_waitcnt vmcnt(0)" ::: "memory")
constexpr float LOG2E = 1.4426950408889634f, LN2 = 0.6931471805599453f;

DI float fexp2(float x) { return __builtin_amdgcn_exp2f(x); }
DI float fexp(float x) { return __builtin_amdgcn_exp2f(x * LOG2E); }
DI float sigmoidf_(float x) { return __builtin_amdgcn_rcpf(1.f + fexp(-x)); }
DI float siluf_(float x) { return x * sigmoidf_(x); }
DI float gelu_tanh(float x) { const float u = 0.7978845608028654f * (x + 0.044715f * x * x * x); const float th = 1.f - 2.f * __builtin_amdgcn_rcpf(fexp(2.f * u) + 1.f); return 0.5f * x * (1.f + th); }
typedef _Float16 f16; typedef _Float16 f16x2_t __attribute__((ext_vector_type(2)));
DI unsigned pkh(float lo, float hi) { f16x2_t v = {(f16)__builtin_amdgcn_fmed3f(lo, -65504.f, 65504.f), (f16)__builtin_amdgcn_fmed3f(hi, -65504.f, 65504.f)}; return __builtin_bit_cast(unsigned, v); }
DI f32x4 h4(unsigned a, unsigned b) { const f16x2_t x = __builtin_bit_cast(f16x2_t, a), y = __builtin_bit_cast(f16x2_t, b); return (f32x4){(float)x[0], (float)x[1], (float)y[0], (float)y[1]}; }
DI int crow(int r, int hi) { return (r & 3) + 8 * (r >> 2) + 4 * hi; }

struct EpiZ {
    static constexpr bool PERM = true;
    bf16* O;
    DI void operator()(const f32x4 (&acc)[2][2][4][2], const pg8::Unit& u, int wr, int wc, int fr, int fq) const {
        const int row0 = u.pm * 256 + wr * 64 + fr, col0 = u.pn * 256 + wc * 32 + 8 * fq;
#pragma unroll
        for (int ai = 0; ai < 2; ++ai)
#pragma unroll
            for (int m = 0; m < 4; ++m) { bf16* rowp = O + (size_t)(row0 + ai * 128 + m * 16) * NZ + col0;
#pragma unroll
                for (int bj = 0; bj < 2; ++bj) { const f32x4 v0 = acc[ai][bj][m][0], v1 = acc[ai][bj][m][1];
                    u32x4 w; w.x = pk2(v0[0], v0[1]); w.y = pk2(v0[2], v0[3]); w.z = pk2(v1[0], v1[1]); w.w = pk2(v1[2], v1[3]);
                    *(u32x4*)(rowp + bj * 128) = w; } }
    }
};
struct EpiRes {
    static constexpr bool PERM = true;
    const float* x; f16* h; const float* modl;
    DI void operator()(const f32x4 (&acc)[2][2][4][2], const pg8::Unit& u, int wr, int wc, int fr, int fq) const {
        const int row0 = u.pm * 256 + wr * 64 + fr, col0 = u.pn * 256 + wc * 32 + 8 * fq;
        const int b = (u.pm * 256) / T; const float* gp = modl + b * 6144 + 2048 + col0;
        f32x4 gv[2][2];
#pragma unroll
        for (int bj = 0; bj < 2; ++bj)
#pragma unroll
            for (int n = 0; n < 2; ++n) gv[bj][n] = *(const f32x4*)(gp + bj * 128 + 4 * n);
#pragma unroll
        for (int ai = 0; ai < 2; ++ai)
#pragma unroll
            for (int m = 0; m < 4; ++m) { const size_t ro = (size_t)(row0 + ai * 128 + m * 16) * D + col0;
#pragma unroll
                for (int bj = 0; bj < 2; ++bj) { f32x4 r0, r1;
                    if (x) { r0 = *(const f32x4*)(x + ro + bj * 128); r1 = *(const f32x4*)(x + ro + bj * 128 + 4); }
                    else { const u32x4 t = *(const u32x4*)(h + ro + bj * 128); r0 = h4(t.x, t.y); r1 = h4(t.z, t.w); }
                    const f32x4 o0 = r0 + gv[bj][0] * acc[ai][bj][m][0], o1 = r1 + gv[bj][1] * acc[ai][bj][m][1];
                    u32x4 w; w.x = pkh(o0.x, o0.y); w.y = pkh(o0.z, o0.w); w.z = pkh(o1.x, o1.y); w.w = pkh(o1.z, o1.w);
                    *(u32x4*)(h + ro + bj * 128) = w; } }
    }
};
struct EpiSwiglu {
    static constexpr bool PERM = true;
    bf16* H;
    DI void operator()(const f32x4 (&acc)[2][2][4][2], const pg8::Unit& u, int wr, int wc, int fr, int fq) const {
        const int row0 = u.pm * 256 + wr * 64 + fr, col0 = u.pl * 128 + wc * 32 + 8 * fq;
#pragma unroll
        for (int ai = 0; ai < 2; ++ai)
#pragma unroll
            for (int m = 0; m < 4; ++m) { bf16* rowp = H + (size_t)(row0 + ai * 128 + m * 16) * FF + col0;
                float o[8];
#pragma unroll
                for (int n = 0; n < 2; ++n)
#pragma unroll
                    for (int j = 0; j < 4; ++j) o[4 * n + j] = siluf_(acc[ai][0][m][n][j]) * acc[ai][1][m][n][j];
                u32x4 w; w.x = pk2(o[0], o[1]); w.y = pk2(o[2], o[3]); w.z = pk2(o[4], o[5]); w.w = pk2(o[6], o[7]);
                *(u32x4*)rowp = w; }
    }
};
struct EpiDown {
    static constexpr bool PERM = true;
    f16* h; float* outf; const float* modl; const int* list; const float* rtw; const LAS int* cnt; int dense, kpass, fin; float* part;
    DI void operator()(const f32x4 (&acc)[2][2][4][2], const pg8::Unit& u, int wr, int wc, int fr, int fq) const {
        if (u.part >= 0) {
            float* pb = part + (size_t)u.part * 65536 + (wr * 64 + fr) * 256 + wc * 32 + 8 * fq;
#pragma unroll
            for (int ai = 0; ai < 2; ++ai)
#pragma unroll
                for (int m = 0; m < 4; ++m)
#pragma unroll
                    for (int bj = 0; bj < 2; ++bj)
#pragma unroll
                        for (int n = 0; n < 2; ++n) *(f32x4*)(pb + (ai * 128 + m * 16) * 256 + bj * 128 + 4 * n) = acc[ai][bj][m][n];
            return; }
        const int r0 = wr * 64 + fr, col0 = u.pl * 256 + wc * 32 + 8 * fq;
        const int ce = dense ? 0 : cnt[u.e];
#pragma unroll
        for (int ai = 0; ai < 2; ++ai)
#pragma unroll
            for (int m = 0; m < 4; ++m) { const int idx = u.lt * 256 + r0 + ai * 128 + m * 16;
                int tok = idx; float w = 1.f; bool ok = true;
                if (!dense) { ok = idx < ce; tok = ok ? list[u.e * 32768 + idx] : 0; w = ok ? rtw[tok * 2 + kpass] : 0.f; }
                if (ok) { const int b = tok >> 13; const float* gp = modl + b * 6144 + 5120 + col0; f16* hp = h + (size_t)tok * D + col0; float* op = outf + (size_t)tok * D + col0;
#pragma unroll
                    for (int bj = 0; bj < 2; ++bj) { const f32x4 g0 = *(const f32x4*)(gp + bj * 128), g1 = *(const f32x4*)(gp + bj * 128 + 4); const u32x4 t = *(const u32x4*)(hp + bj * 128);
                        const f32x4 o0 = h4(t.x, t.y) + (g0 * w) * acc[ai][bj][m][0], o1 = h4(t.z, t.w) + (g1 * w) * acc[ai][bj][m][1];
                        if (fin) { *(f32x4*)(op + bj * 128) = o0; *(f32x4*)(op + bj * 128 + 4) = o1; }
                        else { u32x4 wv; wv.x = pkh(o0.x, o0.y); wv.y = pkh(o0.z, o0.w); wv.z = pkh(o1.x, o1.y); wv.w = pkh(o1.z, o1.w); *(u32x4*)(hp + bj * 128) = wv; } } } }
    }
};

struct Args { const void* in[34]; float* out; unsigned char* ws; };
typedef const __attribute__((address_space(4))) Args& KArgsR;
enum { I_X = 0, I_C, I_POS, I_ADAW, I_ADAB, I_NMG, I_NFG, I_WIN, I_WOUT, I_CONVW, I_LRE, I_LIM, I_BRE, I_BIM, I_CRE, I_CIM, I_SD, I_LDT, I_WGLU, I_QNG, I_KNG, I_PK, I_PV, I_KW1, I_KW2, I_VW1, I_VW2,
       I_FG, I_FU, I_FD, I_MR, I_MG, I_MU, I_MD };

DI void tr_item(const float* W, int ldw, int K, bf16* WT, int dst_row0, int k0, int n0, LAS float* scr, int lane) {
    const int kq = lane >> 4, n4 = (lane & 15) * 4;
    f32x4 v[16];
#pragma unroll
    for (int i = 0; i < 16; ++i) v[i] = *(const f32x4*)(W + (size_t)(k0 + 4 * i + kq) * ldw + n0 + n4);
#pragma unroll
    for (int i = 0; i < 16; ++i) { LAS float* d = scr + (4 * i + kq) * 65 + n4; d[0] = v[i].x; d[1] = v[i].y; d[2] = v[i].z; d[3] = v[i].w; }
    LDS_WAIT(); asm volatile("" ::: "memory");
    const int c = lane & 7;
#pragma unroll
    for (int j = 0; j < 8; ++j) { const int n = (lane >> 3) + 8 * j; const LAS float* s = scr + (8 * c) * 65 + n;
        u32x4 o; o.x = pk2(s[0 * 65], s[1 * 65]); o.y = pk2(s[2 * 65], s[3 * 65]); o.z = pk2(s[4 * 65], s[5 * 65]); o.w = pk2(s[6 * 65], s[7 * 65]);
        *(u32x4*)(WT + (size_t)(dst_row0 + n) * K + k0 + 8 * c) = o; }
    LDS_WAIT(); asm volatile("" ::: "memory");
}
DI int gu_row(int n0, int up) { return (n0 >> 7) * 256 + (n0 & 127) + (up ? 128 : 0); }
constexpr int IT_WIN = 16 * 44, IT_WOUT = 16 * 16, IT_GU = 16 * 56, IT_DN = 56 * 16, IT_C1 = 32 * 4, IT_C2 = 4 * 1, IT_GLU = 4 * 4;
constexpr int IT_TOTAL = 2 * (IT_WIN + IT_WOUT) + (2 * IT_GU + IT_DN) * 9 + 4 * IT_C1 + 4 * IT_C2 + 2 * IT_GLU;
DI void conv_item(KArgsR a, int r, LAS float* scr, int lane) {
    unsigned char* ws = a.ws;
#pragma unroll
    for (int l = 0; l < 2; ++l) {
        if (r < IT_WIN) { const int kb = r / 44, nb = r % 44; tr_item((const float*)a.in[I_WIN] + (size_t)l * D * NIN, NIN, D, (bf16*)(ws + WS_WIN) + (size_t)l * NZ * D, 64 * nb, 64 * kb, 64 * nb, scr, lane); return; } r -= IT_WIN;
        if (r < IT_WOUT) { const int kb = r / 16, nb = r % 16; tr_item((const float*)a.in[I_WOUT] + (size_t)l * D * D, D, D, (bf16*)(ws + WS_WOUT) + (size_t)l * D * D, 64 * nb, 64 * kb, 64 * nb, scr, lane); return; } r -= IT_WOUT;
    }
    if (r < IT_GU) { const int kb = r / 56, nb = r % 56; tr_item((const float*)a.in[I_FG], FF, D, (bf16*)(ws + WS_WGUD), gu_row(64 * nb, 0), 64 * kb, 64 * nb, scr, lane); return; } r -= IT_GU;
    if (r < IT_GU) { const int kb = r / 56, nb = r % 56; tr_item((const float*)a.in[I_FU], FF, D, (bf16*)(ws + WS_WGUD), gu_row(64 * nb, 1), 64 * kb, 64 * nb, scr, lane); return; } r -= IT_GU;
    if (r < IT_DN) { const int kb = r / 16, nb = r % 16; tr_item((const float*)a.in[I_FD], D, FF, (bf16*)(ws + WS_WDD), 64 * nb, 64 * kb, 64 * nb, scr, lane); return; } r -= IT_DN;
    if (r < 8 * (2 * IT_GU + IT_DN)) { const int e = r / (2 * IT_GU + IT_DN); r -= e * (2 * IT_GU + IT_DN);
        if (r < IT_GU) { const int kb = r / 56, nb = r % 56; tr_item((const float*)a.in[I_MG] + (size_t)e * D * FF, FF, D, (bf16*)(ws + WS_WGUM) + (size_t)e * 7168 * D, gu_row(64 * nb, 0), 64 * kb, 64 * nb, scr, lane); return; } r -= IT_GU;
        if (r < IT_GU) { const int kb = r / 56, nb = r % 56; tr_item((const float*)a.in[I_MU] + (size_t)e * D * FF, FF, D, (bf16*)(ws + WS_WGUM) + (size_t)e * 7168 * D, gu_row(64 * nb, 1), 64 * kb, 64 * nb, scr, lane); return; } r -= IT_GU;
        { const int kb = r / 16, nb = r % 16; tr_item((const float*)a.in[I_MD] + (size_t)e * FF * D, D, FF, (bf16*)(ws + WS_WDM) + (size_t)e * D * FF, 64 * nb, 64 * kb, 64 * nb, scr, lane); return; }
    }
    r -= 8 * (2 * IT_GU + IT_DN);
    if (r < 4 * IT_C1) { const int m = r / IT_C1, rr = r % IT_C1, l = m >> 1, kv = m & 1, kb = rr / 4, nb = rr % 4;
        tr_item((const float*)a.in[kv ? I_VW1 : I_KW1] + (size_t)l * 2048 * 256, 256, 2048, (bf16*)(ws + WS_CW1) + (size_t)m * 256 * 2048, 64 * nb, 64 * kb, 64 * nb, scr, lane); return; } r -= 4 * IT_C1;
    if (r < 4 * IT_C2) { const int m = r / IT_C2, rr = r % IT_C2, l = m >> 1, kv = m & 1, kb = rr, nb = 0;
        tr_item((const float*)a.in[kv ? I_VW2 : I_KW2] + (size_t)l * 256 * 64, 64, 256, (bf16*)(ws + WS_CW2) + (size_t)m * 64 * 256, 64 * nb, 64 * kb, 64 * nb, scr, lane); return; } r -= 4 * IT_C2;
    { const int l = r / IT_GLU, rr = r % IT_GLU, kb = rr / 4, nb = rr % 4;
        tr_item((const float*)a.in[I_WGLU] + (size_t)l * 256 * 256, 256, 256, (bf16*)(ws + WS_WGLU) + (size_t)l * 256 * 256, 64 * nb, 64 * kb, 64 * nb, scr, lane); }
}

DI void prologue(KArgsR a, LAS unsigned char* lds, int tid, int lane, int wave, int G) {
    LAS float* condL = (LAS float*)(lds + 98304);
    for (int i = tid; i < 4096; i += 512) condL[i] = siluf_(((const float*)a.in[I_C])[i]);
    __syncthreads();
    const int gw = blockIdx.x * 8 + wave, NGW = G * 8;
    for (int mt = gw; mt < 192; mt += NGW) {
        const int l = mt / 96, n = (mt % 96) * 64 + lane;
        const float* wp = (const float*)a.in[I_ADAW] + (size_t)l * D * 6144 + n;
        float acc[4] = {0.f, 0.f, 0.f, 0.f};
        for (int k0 = 0; k0 < D; k0 += 16) {
            float w[16];
#pragma unroll
            for (int i = 0; i < 16; ++i) w[i] = wp[(size_t)(k0 + i) * 6144];
#pragma unroll
            for (int i = 0; i < 16; ++i)
#pragma unroll
                for (int b = 0; b < 4; ++b) acc[b] += condL[b * 1024 + k0 + i] * w[i];
        }
        const float bias = ((const float*)a.in[I_ADAB])[l * 6144 + n];
#pragma unroll
        for (int b = 0; b < 4; ++b) ((float*)(a.ws + WS_MOD))[(l * 4 + b) * 6144 + n] = acc[b] + bias;
    }
    for (int ct = gw - 192; ct >= 0 && ct < 16; ct += NGW) {
        const int l = ct >> 3, kv = (ct >> 2) & 1, n = (ct & 3) * 64 + lane;
        const float* pos = (const float*)a.in[kv ? I_PV : I_PK] + l * 2048; const float* w1 = (const float*)a.in[kv ? I_VW1 : I_KW1] + (size_t)l * 2048 * 256 + n;
        float acc = 0.f;
        for (int k0 = 0; k0 < 2048; k0 += 16) {
            float w[16];
#pragma unroll
            for (int i = 0; i < 16; ++i) w[i] = w1[(size_t)(k0 + i) * 256];
#pragma unroll
            for (int i = 0; i < 16; ++i) acc += pos[k0 + i] * w[i];
        }
        ((float*)(a.ws + WS_CBIAS))[(l * 2 + kv) * 256 + n] = acc;
    }
    __syncthreads();
    LAS float* scr = (LAS float*)(lds + wave * 16640);
    for (int it = gw; it < IT_TOTAL; it += NGW) conv_item(a, it, scr, lane);
}

template <bool F16> struct NormRaw { typedef u32x4 T; }; template <> struct NormRaw<true> { typedef u32x2 T; };
template <int NS, bool F16, int RPW = 16>
DI void norm_phase(KArgsR a, const void* hin, const float* gain, const float* modl, int sh_off, const float* Wsm, int ldws, LAS unsigned char* lds, int tid, int lane, int wave, int G, int rowbeg = 0, int nrows = M, size_t aoff = OB_A) {
    static_assert(NS != 8 || RPW == 16, "the routing path keeps one row per lane 0..15");
    LAS float* Ws = (LAS float*)lds;
    LAS int* lc = (LAS int*)(lds + LDSCTL_OFF);
    gu32* ctl = (gu32*)(a.ws + WS_CTL);
    bf16* aout = (bf16*)((unsigned char*)a.out + aoff);
    if constexpr (NS > 0) {
        for (int i = tid; i < NS * 1024; i += 512) { const int k = i / NS, n = i % NS; Ws[n * 1024 + k] = Wsm[(size_t)k * ldws + n]; }
        __syncthreads();
    }
    for (int base = blockIdx.x * 8; base < nrows / RPW; base += G * 8) {
        const int rb = base + wave, row0 = rowbeg + rb * RPW, b = row0 / T;
        f32x4 Av[4], Bv[4];
#pragma unroll
        for (int j = 0; j < 4; ++j) { const int col = 4 * lane + 256 * j;
            const f32x4 g4 = *(const f32x4*)(gain + col), sc = *(const f32x4*)(modl + b * 6144 + sh_off + 1024 + col);
            Av[j] = g4 * (sc + 1.0f); Bv[j] = *(const f32x4*)(modl + b * 6144 + sh_off + col); }
        int e0k = 0, e1k = 0, p0k = 0, p1k = 0;
        if constexpr (NS == 8) { if (tid < 16) lc[LC_LCNT + tid] = 0; __syncthreads(); }
        typedef typename NormRaw<F16>::T RawT;
        constexpr int PF = NORM_PF; static_assert(RPW % PF == 0, "ring depth");
        RawT vn[PF][4];
#pragma unroll
        for (int k = 0; k < PF; ++k) { const RawT* xr0 = (const RawT*)hin + (size_t)(row0 + k) * (D / 4) + lane;
#pragma unroll
            for (int j = 0; j < 4; ++j) vn[k][j] = xr0[64 * j]; }
#pragma unroll 1
        for (int rr0 = 0; rr0 < RPW; rr0 += PF) {
#pragma unroll
          for (int k = 0; k < PF; ++k) {
            const int rr = rr0 + k, row = row0 + rr;
            f32x4 v[4]; float ss = 0.f;
#pragma unroll
            for (int j = 0; j < 4; ++j) { if constexpr (F16) v[j] = h4(vn[k][j].x, vn[k][j].y); else v[j] = __builtin_bit_cast(f32x4, vn[k][j]);
                ss += (v[j].x * v[j].x + v[j].y * v[j].y) + (v[j].z * v[j].z + v[j].w * v[j].w); }
            if (rr + PF < RPW) { const RawT* xn = (const RawT*)hin + (size_t)(row + PF) * (D / 4) + lane;
#pragma unroll
                for (int j = 0; j < 4; ++j) vn[k][j] = xn[64 * j]; }
            const float rstd = rsqrtf(wave_sum(ss) * (1.f / D) + RMS_EPS);
            unsigned long long* o8 = (unsigned long long*)(aout + (size_t)row * D) + lane;
#pragma unroll
            for (int j = 0; j < 4; ++j) { v[j] = (v[j] * rstd) * Av[j] + Bv[j];
                o8[64 * j] = (unsigned long long)pk2(v[j].x, v[j].y) | ((unsigned long long)pk2(v[j].z, v[j].w) << 32); }
            if constexpr (NS > 0) {
                constexpr int NV = (NS > 8) ? 16 : 8;
                float pa[NV];
#pragma unroll
                for (int n = 0; n < NV; ++n) { float acc = 0.f;
                    if (n < NS) {
#pragma unroll
                        for (int j = 0; j < 4; ++j) { const f32x4 w = *(const LAS f32x4*)(Ws + n * 1024 + 4 * lane + 256 * j); acc += (v[j].x * w.x + v[j].y * w.y) + (v[j].z * w.z + v[j].w * w.w); } }
                    pa[n] = acc; if ((n & 3) == 3) __builtin_amdgcn_sched_barrier(0); }
#define NP_BFLY(cnt, off) { const bool up = (lane & (off)) != 0; _Pragma("unroll") for (int i = 0; i < (cnt); ++i) { const float keep = up ? pa[i + (cnt)] : pa[i], send = up ? pa[i] : pa[i + (cnt)]; pa[i] = keep + __shfl_xor(send, (off)); } }
                float tot;
                if constexpr (NV == 16) { NP_BFLY(8, 32) NP_BFLY(4, 16) NP_BFLY(2, 8) NP_BFLY(1, 4) tot = pa[0]; tot += __shfl_xor(tot, 2); tot += __shfl_xor(tot, 1); }
                else { NP_BFLY(4, 32) NP_BFLY(2, 16) NP_BFLY(1, 8) tot = pa[0]; tot += __shfl_xor(tot, 4); tot += __shfl_xor(tot, 2); tot += __shfl_xor(tot, 1); }
#undef NP_BFLY
                const float o = __shfl(tot, (lane * (64 / NV)) & 63);
                if constexpr (NS == 12) {
                    if (lane < 12) ((float*)(a.ws + WS_GL))[(size_t)row * 12 + lane] = o;
                } else {
                    const float c0 = (lane < 8) ? o : -3.0e38f; const float v0 = wave_max(c0);
                    const int i0 = __builtin_ctzll(__ballot(c0 == v0));
                    const float c1v = (lane < 8 && lane != i0) ? o : -3.0e38f; const float v1 = wave_max(c1v);
                    const int i1 = __builtin_ctzll(__ballot(c1v == v1 && lane < 8 && lane != i0));
                    const float w0 = __builtin_amdgcn_rcpf(1.f + fexp(v1 - v0));
                    if (lane == 0) { ((float*)(a.ws + WS_RTW))[row * 2] = w0; ((float*)(a.ws + WS_RTW))[row * 2 + 1] = 1.f - w0; }
                    if (lane == rr) { const int lp0 = __hip_atomic_fetch_add(&lc[LC_LCNT + i0], 1, __ATOMIC_RELAXED, __HIP_MEMORY_SCOPE_WORKGROUP); const int lp1 = __hip_atomic_fetch_add(&lc[LC_LCNT + 8 + i1], 1, __ATOMIC_RELAXED, __HIP_MEMORY_SCOPE_WORKGROUP);
                        e0k = i0; e1k = i1; p0k = lp0; p1k = lp1; }
                }
            }
          }
        }
        if constexpr (NS == 8) {
            __syncthreads();
            if (tid < 16) lc[LC_BASE + tid] = (int)__hip_atomic_fetch_add(ctl + CW_CNT + tid * 64, (unsigned)lc[LC_LCNT + tid], RLX_AGENT);
            __syncthreads();
            if (lane < 16) { int* list = (int*)(a.ws + WS_LIST);
                list[(0 * 8 + e0k) * 32768 + lc[LC_BASE + e0k] + p0k] = row0 + lane;
                list[(1 * 8 + e1k) * 32768 + lc[LC_BASE + 8 + e1k] + p1k] = row0 + lane; }
            __syncthreads();
        }
    }
}

DI u32x4 ldg16(const bf16* p) { return *(const u32x4*)p; }

DI void conv_tile(KArgsR a, int l, int b, int t0, int tid) {
    const bf16* z = (const bf16*)(a.ws + WS_Z); bf16* y = (bf16*)(a.ws + WS_Y);
    const float* cw = (const float*)a.in[I_CONVW] + l * 3 * 256;
    for (int it = tid; it < 64 * 32; it += 512) {
        const int tl = it >> 5, c8 = (it & 31) * 8, t = t0 + tl; const size_t row = (size_t)b * T + t;
        float acc[8];
#pragma unroll
        for (int i = 0; i < 8; ++i) acc[i] = 0.f;
#pragma unroll
        for (int jj = 0; jj < 3; ++jj) { const int tt = t - 2 + jj;
            if (tt >= 0) { const size_t r2 = (size_t)b * T + tt; const u32x4 gc = ldg16(z + r2 * NZ + ZC_CC + c8), uu = ldg16(z + r2 * NZ + ZC_CU + c8);
                const f32x4 w0 = *(const f32x4*)(cw + jj * 256 + c8), w1 = *(const f32x4*)(cw + jj * 256 + c8 + 4);
                acc[0] += w0.x * (bflo(gc.x) * bflo(uu.x)); acc[1] += w0.y * (bfhi(gc.x) * bfhi(uu.x)); acc[2] += w0.z * (bflo(gc.y) * bflo(uu.y)); acc[3] += w0.w * (bfhi(gc.y) * bfhi(uu.y));
                acc[4] += w1.x * (bflo(gc.z) * bflo(uu.z)); acc[5] += w1.y * (bfhi(gc.z) * bfhi(uu.z)); acc[6] += w1.z * (bflo(gc.w) * bflo(uu.w)); acc[7] += w1.w * (bfhi(gc.w) * bfhi(uu.w)); } }
        const u32x4 gb = ldg16(z + row * NZ + ZC_CB + c8);
        u32x4 o; o.x = pk2(bflo(gb.x) * acc[0], bfhi(gb.x) * acc[1]); o.y = pk2(bflo(gb.y) * acc[2], bfhi(gb.y) * acc[3]); o.z = pk2(bflo(gb.z) * acc[4], bfhi(gb.z) * acc[5]); o.w = pk2(bflo(gb.w) * acc[6], bfhi(gb.w) * acc[7]);
        *(u32x4*)(y + row * D + c8) = o;
    }
}
DI float norm_rope(float x, float gain, float cs, float sn, int lane) {
    const float ss = wave_sum(x * x); const float r = rsqrtf(ss * (1.f / 64.f) + RMS_EPS);
    const float xn = x * r * gain; const float pr = __shfl_xor(xn, 32);
    return (lane < 32) ? (xn * cs - pr * sn) : (xn * cs + pr * sn);
}
DI void rope_cs(int pos, int lane, float& cs, float& sn) {
    const int i = lane & 31; const float inv = exp2f(-(float)i * (13.287712379549449f / 32.f));
    const float ang = (float)pos * inv; sincosf(ang, &sn, &cs);
}
DI void prep_tile(KArgsR a, int l, int b, int t0, LAS unsigned char* lds, int tid, int lane, int wave) {
    bf16* z = (bf16*)(a.ws + WS_Z);
    const float qg = ((const float*)a.in[I_QNG])[l * 64 + lane], kg = ((const float*)a.in[I_KNG])[l * 64 + lane];
    const int* posp = (const int*)a.in[I_POS];
#pragma unroll 1
    for (int i = 0; i < 8; ++i) {
        const int t = t0 + wave * 8 + i; const size_t row = (size_t)b * T + t;
        unsigned raw[8];
#pragma unroll
        for (int hh = 0; hh < 8; ++hh) { const int col = (hh < 4) ? ZC_NQ + hh * 64 : (hh < 6 ? ZC_KV + 2 * 128 + (hh - 4) * 64 : ZC_KV + 4 * 128 + (hh - 6) * 64); raw[hh] = z[row * NZ + col + lane]; }
        unsigned rawk[4];
#pragma unroll
        for (int hd = 0; hd < 4; ++hd) rawk[hd] = z[row * NZ + ZC_SBK + hd * 64 + lane];
        float cs, sn; rope_cs(posp[row], lane, cs, sn);
#pragma unroll
        for (int hd = 0; hd < 4; ++hd) { bf16* kf = (bf16*)((unsigned char*)a.out + OB_KFSB) + (size_t)(b * 4 + hd) * T * 64;
            kf[((size_t)((t >> 5) * 4 + (lane >> 4)) * 64 + (t & 31) + 32 * ((lane >> 3) & 1)) * 8 + (lane & 7)] = (bf16)rawk[hd]; }
#pragma unroll
        for (int hh = 0; hh < 8; ++hh) {
            const int col = (hh < 4) ? ZC_NQ + hh * 64 : (hh < 6 ? ZC_KV + 2 * 128 + (hh - 4) * 64 : ZC_KV + 4 * 128 + (hh - 6) * 64);
            const float o = norm_rope(bf2f(raw[hh]), hh < 4 ? qg : kg, cs, sn, lane);
            z[row * NZ + col + lane] = (bf16)f2bf(o);
            if (hh >= 4) {
                bf16* kf = (bf16*)((unsigned char*)a.out + (hh < 6 ? OB_KFSLC : OB_KFWIN)) + (size_t)(b * 2 + (hh & 1)) * T * 64;
                kf[((size_t)((t >> 5) * 4 + (lane >> 4)) * 64 + (t & 31) + 32 * ((lane >> 3) & 1)) * 8 + (lane & 7)] = (bf16)f2bf(o); }
        }
    }
    LAS unsigned* scr = (LAS unsigned*)(lds + 32768 + wave * 1280);
    for (int cb = wave; cb < 64; cb += 8) {
        const int c0 = 8 * cb; int zc0;
        if (c0 < 256) zc0 = ZC_SBV + c0; else if (c0 < 384) zc0 = ZC_KV + 3 * 128 + (c0 - 256); else zc0 = ZC_KV + 5 * 128 + (c0 - 384);
        const u32x4 v = *(const u32x4*)(z + ((size_t)b * T + t0 + lane) * NZ + zc0);
        scr[lane * 5 + 0] = v.x; scr[lane * 5 + 1] = v.y; scr[lane * 5 + 2] = v.z; scr[lane * 5 + 3] = v.w;
        LDS_WAIT();
        const int ch = lane >> 3, o = lane & 7; const LAS bf16* sp = (const LAS bf16*)scr + ch;
        unsigned e[8];
#pragma unroll
        for (int j = 0; j < 8; ++j) e[j] = sp[(8 * o + j) * 10];
        const int c = c0 + ch, d = c & 63, key = t0 + 8 * o, kt = key >> 5, kk = key & 31, sp2 = kk >> 4, jh = (kk >> 3) & 1;
        bf16* base = (c < 256) ? (bf16*)((unsigned char*)a.out + OB_VFSB) + (size_t)(b * 4 + (c >> 6)) * T * 64 : (c < 384) ? (bf16*)((unsigned char*)a.out + OB_VFSLC) + (size_t)(b * 2 + ((c - 256) >> 6)) * T * 64 : (bf16*)((unsigned char*)a.out + OB_VFWIN) + (size_t)(b * 2 + ((c - 384) >> 6)) * T * 64;
        bf16* vf = base + ((size_t)((kt * 2 + (d >> 5)) * 2 + sp2) * 64 + (d & 31)) * 8 + 4 * jh;
        *(u32x2*)vf = (u32x2){e[0] | (e[1] << 16), e[2] | (e[3] << 16)};
        *(u32x2*)(vf + 32 * 8) = (u32x2){e[4] | (e[5] << 16), e[6] | (e[7] << 16)};
        LDS_WAIT();
    }
}

struct S5P { float lbr, lbi; float br[16], bi[16]; };
DI void s5_params(KArgsR a, int l, int g, int p, S5P& P) {
    const int gi = (l * 16 + g) * 64 + p;
    const float lre = fminf(((const float*)a.in[I_LRE])[gi], -1e-4f), lim = ((const float*)a.in[I_LIM])[gi];
    const float dt = expf(((const float*)a.in[I_LDT])[l * 16 + g]);
    const float mag = expf(lre * dt); float s, c; sincosf(lim * dt, &s, &c);
    P.lbr = mag * c; P.lbi = mag * s;
    const float nr = P.lbr - 1.f, ni = P.lbi, den = 1.f / (lre * lre + lim * lim);
    const float cr = (nr * lre + ni * lim) * den, ci = (ni * lre - nr * lim) * den;
    const float* bre = (const float*)a.in[I_BRE] + (size_t)gi * 16; const float* bim = (const float*)a.in[I_BIM] + (size_t)gi * 16;
#pragma unroll
    for (int q = 0; q < 4; ++q) { const f32x4 r4 = *(const f32x4*)(bre + 4 * q), i4 = *(const f32x4*)(bim + 4 * q);
#pragma unroll
        for (int j = 0; j < 4; ++j) { P.br[4 * q + j] = cr * r4[j] - ci * i4[j]; P.bi[4 * q + j] = cr * i4[j] + ci * r4[j]; } }
}
DI void s5_load_ublock(const bf16* z, int b, int tc0, LAS unsigned char* ub, int tid) {
#pragma unroll
    for (int k = 0; k < 4; ++k) { const int it = tid + 512 * k, r = it >> 5, c16 = it & 31;
        *(LAS u32x4*)(ub + r * 528 + c16 * 16) = *(const u32x4*)(z + ((size_t)b * T + tc0 + r) * NZ + ZC_SSM + c16 * 8); }
    __syncthreads();
}
DI void s5_stage_u(const LAS unsigned char* ub, int g, LAS float* us, int lane) {
    const LAS u32x4* p = (const LAS u32x4*)(ub + lane * 528 + g * 32);
    const u32x4 v0 = p[0], v1 = p[1];
    LAS f32x4* d = (LAS f32x4*)(us + lane * 16);
    d[0] = (f32x4){bflo(v0.x), bfhi(v0.x), bflo(v0.y), bfhi(v0.y)}; d[1] = (f32x4){bflo(v0.z), bfhi(v0.z), bflo(v0.w), bfhi(v0.w)};
    d[2] = (f32x4){bflo(v1.x), bfhi(v1.x), bflo(v1.y), bfhi(v1.y)}; d[3] = (f32x4){bflo(v1.z), bfhi(v1.z), bflo(v1.w), bfhi(v1.w)};
    LDS_WAIT();
}
DI void s5_bu(const S5P& P, const LAS float* ut, float& bur, float& bui) {
    const f32x4 u0 = *(const LAS f32x4*)(ut), u1 = *(const LAS f32x4*)(ut + 4), u2 = *(const LAS f32x4*)(ut + 8), u3 = *(const LAS f32x4*)(ut + 12);
    float ar = 0.f, ai = 0.f, cr = 0.f, ci = 0.f;
#pragma unroll
    for (int j = 0; j < 4; ++j) { ar += P.br[j] * u0[j]; ai += P.bi[j] * u0[j]; cr += P.br[4 + j] * u1[j]; ci += P.bi[4 + j] * u1[j]; }
#pragma unroll
    for (int j = 0; j < 4; ++j) { ar += P.br[8 + j] * u2[j]; ai += P.bi[8 + j] * u2[j]; cr += P.br[12 + j] * u3[j]; ci += P.bi[12 + j] * u3[j]; }
    bur = ar + cr; bui = ai + ci;
}
DI void s5_rec(const S5P& P, float bur, float bui, float& hr, float& hi) { const float nr = P.lbr * hr - P.lbi * hi + bur, ni = P.lbr * hi + P.lbi * hr + bui; hr = nr; hi = ni; }
DI void s5_pass1(KArgsR a, int l, int b, int ch, LAS unsigned char* lds, int tid, int lane, int wave) {
    const bf16* z = (const bf16*)(a.ws + WS_Z); LAS float* us = (LAS float*)(lds + wave * 4096); LAS unsigned char* ub = lds + 49152;
    __syncthreads();
    s5_load_ublock(z, b, ch * 64, ub, tid);
    for (int gg = 0; gg < 2; ++gg) {
        const int g = wave * 2 + gg; S5P P; s5_params(a, l, g, lane, P);
        s5_stage_u(ub, g, us, lane);
        float hr = 0.f, hi = 0.f;
#pragma unroll 1
        for (int t = 0; t < 64; t += 4) { float br4[4], bi4[4];
#pragma unroll
            for (int k = 0; k < 4; ++k) s5_bu(P, us + (t + k) * 16, br4[k], bi4[k]);
#pragma unroll
            for (int k = 0; k < 4; ++k) s5_rec(P, br4[k], bi4[k], hr, hi); }
        ((f32x2*)(a.ws + WS_S5E))[((size_t)(b * 16 + g) * 128 + ch) * 64 + lane] = (f32x2){hr, hi};
        LDS_WAIT();
    }
}

DI void cmp_task(KArgsR a, int l, int task, LAS unsigned char* lds, int tid, int lane, int wave) {
    const int itile = task & 15, g = (task >> 4) & 1, b = (task >> 5) & 3, kv = task >> 7;
    const bf16* z = (const bf16*)(a.ws + WS_Z);
    const bf16* w1t = (const bf16*)(a.ws + WS_CW1) + (size_t)(l * 2 + kv) * 256 * 2048;
    const bf16* w2t = (const bf16*)(a.ws + WS_CW2) + (size_t)(l * 2 + kv) * 64 * 256;
    const float* cb = (const float*)(a.ws + WS_CBIAS) + (l * 2 + kv) * 256;
    LAS bf16* Hs = (LAS bf16*)lds;
    LAS float* Os = (LAS float*)(lds + 32 * 264 * 2);
    const int fr = lane & 15, fq = lane >> 4, i0 = itile * 32;
    const int zc = ZC_KV + kv * 128 + g * 64;
    f32x4 acc[2][2];
#pragma unroll
    for (int rb = 0; rb < 2; ++rb)
#pragma unroll
        for (int cbk = 0; cbk < 2; ++cbk) acc[rb][cbk] = (f32x4){0.f, 0.f, 0.f, 0.f};
    const bf16* arow[2];
#pragma unroll
    for (int rb = 0; rb < 2; ++rb) arow[rb] = z + ((size_t)b * T + 16 * (i0 + 16 * rb + fr)) * NZ + zc + 8 * fq;
    const bf16* brow[2];
#pragma unroll
    for (int cbk = 0; cbk < 2; ++cbk) brow[cbk] = w1t + (size_t)(32 * wave + 16 * cbk + fr) * 2048 + 8 * fq;
#pragma unroll 4
    for (int ks = 0; ks < 64; ++ks) {
        const int j = ks >> 1, d0 = (ks & 1) * 32;
        bf16x8 af[2], bfr[2];
#pragma unroll
        for (int rb = 0; rb < 2; ++rb) af[rb] = *(const bf16x8*)(arow[rb] + (size_t)j * NZ + d0);
#pragma unroll
        for (int cbk = 0; cbk < 2; ++cbk) bfr[cbk] = *(const bf16x8*)(brow[cbk] + 32 * ks);
#pragma unroll
        for (int rb = 0; rb < 2; ++rb)
#pragma unroll
            for (int cbk = 0; cbk < 2; ++cbk) acc[rb][cbk] = __builtin_amdgcn_mfma_f32_16x16x32_bf16(af[rb], bfr[cbk], acc[rb][cbk], 0, 0, 0);
    }
#pragma unroll
    for (int rb = 0; rb < 2; ++rb)
#pragma unroll
        for (int cbk = 0; cbk < 2; ++cbk) { const int n = 32 * wave + 16 * cbk + fr; const float bias = cb[n];
#pragma unroll
            for (int jj = 0; jj < 4; ++jj) Hs[(16 * rb + 4 * fq + jj) * 264 + n] = (bf16)f2bf(siluf_(acc[rb][cbk][jj] + bias)); }
    __syncthreads();
    { const int rb = wave >> 2, cbk = wave & 3; f32x4 o = (f32x4){0.f, 0.f, 0.f, 0.f};
#pragma unroll
        for (int ks = 0; ks < 8; ++ks) { const bf16x8 af = *(const LAS bf16x8*)(Hs + (16 * rb + fr) * 264 + 32 * ks + 8 * fq);
            const bf16x8 bfr = *(const bf16x8*)(w2t + (size_t)(16 * cbk + fr) * 256 + 32 * ks + 8 * fq);
            o = __builtin_amdgcn_mfma_f32_16x16x32_bf16(af, bfr, o, 0, 0, 0); }
#pragma unroll
        for (int jj = 0; jj < 4; ++jj) Os[(16 * rb + 4 * fq + jj) * 65 + 16 * cbk + fr] = o[jj]; }
    __syncthreads();
    if (kv == 0) {
        const float kg = ((const float*)a.in[I_KNG])[l * 64 + lane];
        bf16* kf = (bf16*)(a.ws + WS_KC) + (size_t)(b * 2 + g) * 512 * 64;
        for (int r = 0; r < 4; ++r) { const int il = wave * 4 + r, i = i0 + il; float o = 0.f;
            if (i < NC) { float cs, sn; rope_cs(((const int*)a.in[I_POS])[b * T + 16 * i + 31], lane, cs, sn); o = norm_rope(Os[il * 65 + lane], kg, cs, sn, lane); }
            kf[((size_t)((i >> 5) * 4 + (lane >> 4)) * 64 + (i & 31) + 32 * ((lane >> 3) & 1)) * 8 + (lane & 7)] = (bf16)f2bf(o); }
    } else {
        const int d = tid >> 3, i4 = (tid & 7) * 4;
        float v[4];
#pragma unroll
        for (int jj = 0; jj < 4; ++jj) v[jj] = (i0 + i4 + jj < NC) ? Os[(i4 + jj) * 65 + d] : 0.f;
        u32x2 w; w.x = pk2(v[0], v[1]); w.y = pk2(v[2], v[3]);
        const int key = i0 + i4, kt = key >> 5, kk = key & 31, sp = kk >> 4, jh = (kk >> 3) & 1, hh = (kk >> 2) & 1;
        bf16* vf = (bf16*)(a.ws + WS_VCT) + (size_t)(b * 2 + g) * 512 * 64 + ((size_t)((kt * 2 + (d >> 5)) * 2 + sp) * 64 + (d & 31) + 32 * hh) * 8 + 4 * jh;
        *(u32x2*)vf = w;
    }
    __syncthreads();
}

DI void s5_carry(KArgsR a, int l, int bg, int lane, gu32* flag) {
    const int b = bg >> 4, g = bg & 15; S5P P; s5_params(a, l, g, lane, P);
    float lr = P.lbr, li = P.lbi;
#pragma unroll
    for (int i = 0; i < 6; ++i) { const float nr = lr * lr - li * li, t2 = lr * li, ni = t2 + t2; lr = nr; li = ni; }
    const f32x2* E = (const f32x2*)(a.ws + WS_S5E) + (size_t)(b * 16 + g) * 128 * 64 + lane;
    typedef GAS unsigned long long gu64;
    gu64* C = (gu64*)(a.ws + WS_S5C) + (size_t)(b * 16 + g) * 128 * 64 + lane;
    float hr = 0.f, hi = 0.f;
#pragma unroll 1
    for (int k0 = 0; k0 < 128; k0 += 8) {
        f32x2 e[8];
#pragma unroll
        for (int i = 0; i < 8; ++i) e[i] = E[(size_t)(k0 + i) * 64];
#pragma unroll
        for (int i = 0; i < 8; ++i) {
            const unsigned long long bits = (unsigned long long)__builtin_bit_cast(unsigned, hr) | ((unsigned long long)__builtin_bit_cast(unsigned, hi) << 32);
            __hip_atomic_store(C + (size_t)(k0 + i) * 64, bits, RLX_AGENT);
            const float nr = lr * hr - li * hi + e[i].x, ni = lr * hi + li * hr + e[i].y; hr = nr; hi = ni; }
    }
    asm volatile("s_waitcnt vmcnt(0)" ::: "memory");
    if (lane == 0) __hip_atomic_fetch_add(flag, 1u, RLX_AGENT);
}
DI void s5_carry_wait(gu32* flag, int tid) {
    if (tid == 0) { unsigned sp = 0; while (__hip_atomic_load(flag, RLX_AGENT) < 64u) { __builtin_amdgcn_s_sleep(2); if (++sp > (1u << 22)) break; }
        __builtin_amdgcn_fence(__ATOMIC_ACQUIRE, "agent"); asm volatile("s_waitcnt vmcnt(0)" ::: "memory"); }
    __syncthreads();
}
DI void s5_pass2(KArgsR a, int l, int b, int ch, LAS unsigned char* lds, int tid, int lane, int wave) {
    const bf16* z = (const bf16*)(a.ws + WS_Z); bf16* y = (bf16*)(a.ws + WS_Y);
    LAS bf16* Gt = (LAS bf16*)lds;
    LAS float* us = (LAS float*)(lds + 34816 + wave * 8704);
    LAS unsigned* Hs = (LAS unsigned*)(lds + 34816 + wave * 8704 + 4096);
    const int fr = lane & 15, fq = lane >> 4, tc0 = ch * 64; LAS unsigned char* ub = lds + 104448;
    s5_load_ublock(z, b, tc0, ub, tid);
    for (int gg = 0; gg < 2; ++gg) {
        const int g = wave * 2 + gg; S5P P; s5_params(a, l, g, lane, P);
        const f32x2 c0 = ((const f32x2*)(a.ws + WS_S5C))[((size_t)(b * 16 + g) * 128 + ch) * 64 + lane];
        float hr = c0.x, hi = c0.y;
        bf16x8 Bf[4];
        { const float* cre = (const float*)a.in[I_CRE] + ((size_t)(l * 16 + g) * 16 + fr) * 64; const float* cim = (const float*)a.in[I_CIM] + ((size_t)(l * 16 + g) * 16 + fr) * 64;
#pragma unroll
            for (int ks = 0; ks < 4; ++ks) { const f32x4 r4 = *(const f32x4*)(cre + 16 * ks + 4 * fq), i4 = *(const f32x4*)(cim + 16 * ks + 4 * fq);
                u32x4 w; w.x = pk2(r4.x, -i4.x); w.y = pk2(r4.y, -i4.y); w.z = pk2(r4.z, -i4.z); w.w = pk2(r4.w, -i4.w); Bf[ks] = __builtin_bit_cast(bf16x8, w); } }
        const float dsk = ((const float*)a.in[I_SD])[l * 256 + g * 16 + fr];
        s5_stage_u(ub, g, us, lane);
        for (int tb = 0; tb < 64; tb += 16) {
#pragma unroll 1
            for (int t = 0; t < 16; t += 4) { float br4[4], bi4[4];
#pragma unroll
                for (int k = 0; k < 4; ++k) s5_bu(P, us + (tb + t + k) * 16, br4[k], bi4[k]);
#pragma unroll
                for (int k = 0; k < 4; ++k) { s5_rec(P, br4[k], bi4[k], hr, hi); Hs[(t + k) * 68 + lane] = pk2(hr, hi); } }
            LDS_WAIT();
            f32x4 Y = (f32x4){0.f, 0.f, 0.f, 0.f};
#pragma unroll
            for (int ks = 0; ks < 4; ++ks) { const bf16x8 af = __builtin_bit_cast(bf16x8, *(const LAS u32x4*)(Hs + fr * 68 + 16 * ks + 4 * fq)); Y = __builtin_amdgcn_mfma_f32_16x16x32_bf16(af, Bf[ks], Y, 0, 0, 0); }
#pragma unroll
            for (int jj = 0; jj < 4; ++jj) { const int t = tb + 4 * fq + jj; const float yv = Y[jj] + dsk * us[t * 16 + fr];
                Gt[t * 264 + g * 16 + fr] = (bf16)f2bf(gelu_tanh(yv)); }
            LDS_WAIT();
        }
    }
    __syncthreads();
    { const bf16* wg = (const bf16*)(a.ws + WS_WGLU) + (size_t)l * 256 * 256;
        f32x4 acc[4][2];
#pragma unroll
        for (int rb = 0; rb < 4; ++rb)
#pragma unroll
            for (int cbk = 0; cbk < 2; ++cbk) acc[rb][cbk] = (f32x4){0.f, 0.f, 0.f, 0.f};
#pragma unroll 2
        for (int ks = 0; ks < 8; ++ks) {
            bf16x8 bfr[2];
#pragma unroll
            for (int cbk = 0; cbk < 2; ++cbk) bfr[cbk] = *(const bf16x8*)(wg + (size_t)(32 * wave + 16 * cbk + fr) * 256 + 32 * ks + 8 * fq);
#pragma unroll
            for (int rb = 0; rb < 4; ++rb) { const bf16x8 af = *(const LAS bf16x8*)(Gt + (16 * rb + fr) * 264 + 32 * ks + 8 * fq);
#pragma unroll
                for (int cbk = 0; cbk < 2; ++cbk) acc[rb][cbk] = __builtin_amdgcn_mfma_f32_16x16x32_bf16(af, bfr[cbk], acc[rb][cbk], 0, 0, 0); }
        }
#pragma unroll
        for (int rb = 0; rb < 4; ++rb)
#pragma unroll
            for (int cbk = 0; cbk < 2; ++cbk)
#pragma unroll
                for (int jj = 0; jj < 4; ++jj) { const int t = 16 * rb + 4 * fq + jj, n = 32 * wave + 16 * cbk + fr;
                    const float gv = bf2f(Gt[t * 264 + n]);
                    y[((size_t)b * T + tc0 + t) * D + 256 + n] = (bf16)f2bf(gv * sigmoidf_(acc[rb][cbk][jj])); }
    }
    __syncthreads();
}

#define MFMA32(a, b, c) __builtin_amdgcn_mfma_f32_32x32x16_bf16((a), (b), (c), 0, 0, 0)
DI void ld_frag4(bf16x8 (&f)[4], const bf16* rowp, int h) {
#pragma unroll
    for (int s = 0; s < 4; ++s) f[s] = *(const bf16x8*)(rowp + 16 * s + 8 * h);
}
DI bf16x8 pack8(const float* p) { u32x4 w; w.x = pk2(p[0], p[1]); w.y = pk2(p[2], p[3]); w.z = pk2(p[4], p[5]); w.w = pk2(p[6], p[7]); return __builtin_bit_cast(bf16x8, w); }
DI f32x16 zero16() { f32x16 z;
#pragma unroll
    for (int i = 0; i < 16; ++i) z[i] = 0.f; return z; }

DI void sb_task(KArgsR a, int task, int lane) {
    const int qt = 255 - (task >> 4), b = (task >> 2) & 3, hd = task & 3;
    const bf16* z = (const bf16*)(a.ws + WS_Z); bf16* y = (bf16*)(a.ws + WS_Y);
    const int q = lane & 31, h = lane >> 5, t0 = qt * 32, t = t0 + q;
    bf16x8 Qf[4]; ld_frag4(Qf, z + ((size_t)b * T + t) * NZ + ZC_SBQ + hd * 64, h);
    const bf16* kfb = (const bf16*)((unsigned char*)a.out + OB_KFSB) + (size_t)(b * 4 + hd) * T * 64 + (size_t)lane * 8;
    const bf16* vfb = (const bf16*)((unsigned char*)a.out + OB_VFSB) + (size_t)(b * 4 + hd) * T * 64 + (size_t)lane * 8;
    f32x16 O0 = zero16(), O1 = zero16();
    float A = 0.f;
    bf16x8 Kn[4], Vn[4];
#pragma unroll
    for (int f = 0; f < 4; ++f) { Kn[f] = *(const bf16x8*)(kfb + (size_t)(qt * 4 + f) * 512); Vn[f] = *(const bf16x8*)(vfb + (size_t)(qt * 4 + f) * 512); }
    for (int kt = qt; kt >= 0; --kt) {
        const int key0 = kt * 32;
        bf16x8 Kf[4], V0[2], V1[2];
#pragma unroll
        for (int f = 0; f < 4; ++f) Kf[f] = Kn[f];
        V0[0] = Vn[0]; V0[1] = Vn[1]; V1[0] = Vn[2]; V1[1] = Vn[3];
        if (kt > 0) {
#pragma unroll
            for (int f = 0; f < 4; ++f) { Kn[f] = *(const bf16x8*)(kfb + (size_t)((kt - 1) * 4 + f) * 512); Vn[f] = *(const bf16x8*)(vfb + (size_t)((kt - 1) * 4 + f) * 512); } }
        f32x16 S = zero16();
#pragma unroll
        for (int s = 0; s < 4; ++s) S = MFMA32(Kf[s], Qf[s], S);
        float ls[16], lk[16];
#pragma unroll
        for (int i = 0; i < 16; ++i) { const int key = key0 + crow(i, h); const bool valid = key < t;
            const float zz = S[i] * 0.125f; const float e = fexp2(-fabsf(zz) * LOG2E); const float l1p = __builtin_amdgcn_logf(1.f + e) * LN2;
            ls[i] = fminf(zz, 0.f) - l1p;
            lk[i] = valid ? (ls[i] - zz) : 0.f; }
        float Gs[4], Gp[4];
#pragma unroll
        for (int g4 = 0; g4 < 4; ++g4) { Gs[g4] = (lk[4 * g4] + lk[4 * g4 + 1]) + (lk[4 * g4 + 2] + lk[4 * g4 + 3]); Gp[g4] = __shfl_xor(Gs[g4], 32); }
        float w[16]; float after = 0.f;
#pragma unroll
        for (int g4 = 3; g4 >= 0; --g4) {
            const float base = A + after + (h == 0 ? Gp[g4] : 0.f);
            float suf = 0.f;
#pragma unroll
            for (int jj = 3; jj >= 0; --jj) { const int i = 4 * g4 + jj; const int key = key0 + crow(i, h);
                const float lw = ls[i] + base + suf; w[i] = (key < t) ? fexp2(lw * LOG2E) : 0.f; suf += lk[i]; }
            after += Gs[g4] + Gp[g4];
        }
        A += after;
        const bf16x8 P0 = pack8(w), P1 = pack8(w + 8);
        O0 = MFMA32(V0[0], P0, O0); O0 = MFMA32(V0[1], P1, O0); O1 = MFMA32(V1[0], P0, O1); O1 = MFMA32(V1[1], P1, O1);
        if (__all(A < -40.f)) break;
    }
    bf16* yo = y + ((size_t)b * T + t) * D + 512 + hd * 64;
#pragma unroll
    for (int g4 = 0; g4 < 4; ++g4) { u32x2 w0, w1; w0.x = pk2(O0[4 * g4], O0[4 * g4 + 1]); w0.y = pk2(O0[4 * g4 + 2], O0[4 * g4 + 3]); w1.x = pk2(O1[4 * g4], O1[4 * g4 + 1]); w1.y = pk2(O1[4 * g4 + 2], O1[4 * g4 + 3]);
        *(u32x2*)(yo + 8 * g4 + 4 * h) = w0; *(u32x2*)(yo + 32 + 8 * g4 + 4 * h) = w1; }
}

DI unsigned wave_or(unsigned v) {
#pragma unroll
    for (int o = 1; o < 64; o <<= 1) v |= (unsigned)__shfl_xor((int)v, o);
    return v;
}
DI void nsa_block(KArgsR a, int l, int qs, int combo, LAS unsigned char* lds, LAS int* lc, int tid_in, int lane_in, int wave) {
    int tid = tid_in; asm volatile("" : "+v"(tid)); const int lane = tid & 63; (void)lane_in;
    const int b = (combo >> 2) & 3, g = (combo >> 1) & 1, hd_task = combo & 1;
    const bf16* z = (const bf16*)(a.ws + WS_Z); bf16* y = (bf16*)(a.ws + WS_Y);
    LAS float* U = (LAS float*)(lds + wave * 16384);
    const int q = lane & 31, h = lane >> 5, qt = 8 * qs + wave, t0 = qt * 32, t = t0 + q, cur = t0 >> 6;
    const size_t rowq = (size_t)b * T + t;
    const float bq = wave_max(fabsf(((const float*)a.in[I_QNG])[l * 64 + lane])), bk = wave_max(fabsf(((const float*)a.in[I_KNG])[l * 64 + lane]));
    const float c1 = 0.125f * LOG2E, c2 = 8.f * bq * bk * LOG2E;
    for (int i = lane; i < 1024; i += 64) ((LAS f32x4*)U)[i] = (f32x4){0.f, 0.f, 0.f, 0.f};
    if (tid < 4) lc[LC_UNI + tid] = 0;
    __syncthreads();
    const int imq = (t >= 31) ? ((t - 31) >> 4) : -1;
    const int ntc = (qs >> 1) + 1;
    const bf16* kcf = (const bf16*)(a.ws + WS_KC) + (size_t)(b * 2 + g) * 512 * 64 + (size_t)lane * 8;
    const bf16* vcf = (const bf16*)(a.ws + WS_VCT) + (size_t)(b * 2 + g) * 512 * 64 + (size_t)lane * 8;
    const int nfull_c = (qt > 0) ? ((((32 * qt - 31) >> 4) + 1) >> 5) : 0;
    float inv[2];
    {
        bf16x8 Qf[2][4];
#pragma unroll
        for (int hd = 0; hd < 2; ++hd) ld_frag4(Qf[hd], z + rowq * NZ + ZC_NQ + (2 * g + hd) * 64, h);
        float lsum[2] = {0.f, 0.f};
        bf16x8 Kn[4];
#pragma unroll
        for (int f = 0; f < 4; ++f) Kn[f] = *(const bf16x8*)(kcf + (size_t)f * 512);
#pragma unroll 1
        for (int it = 0; it < ntc; ++it) {
            bf16x8 Kf[4];
#pragma unroll
            for (int f = 0; f < 4; ++f) Kf[f] = Kn[f];
            if (it + 1 < ntc) {
#pragma unroll
                for (int f = 0; f < 4; ++f) Kn[f] = *(const bf16x8*)(kcf + (size_t)((it + 1) * 4 + f) * 512); }
#pragma unroll
            for (int hd = 0; hd < 2; ++hd) { f32x16 S = zero16();
#pragma unroll
                for (int s = 0; s < 4; ++s) S = MFMA32(Kf[s], Qf[hd][s], S);
                if (it < nfull_c) {
#pragma unroll
                    for (int i = 0; i < 16; ++i) lsum[hd] += fexp2(S[i] * c1 - c2);
                } else {
#pragma unroll
                    for (int i = 0; i < 16; ++i) { const int key = 32 * it + crow(i, h); lsum[hd] += (key <= imq) ? fexp2(S[i] * c1 - c2) : 0.f; } } }
        }
#pragma unroll
        for (int hd = 0; hd < 2; ++hd) { const float s = lsum[hd] + __shfl_xor(lsum[hd], 32); inv[hd] = (s > 0.f) ? 1.f / s : 0.f; }
        float carry[2] = {0.f, 0.f};
#pragma unroll
        for (int f = 0; f < 4; ++f) Kn[f] = *(const bf16x8*)(kcf + (size_t)f * 512);
#pragma unroll 1
        for (int it = 0; it < ntc; ++it) {
            bf16x8 Kf[4];
#pragma unroll
            for (int f = 0; f < 4; ++f) Kf[f] = Kn[f];
            if (it + 1 < ntc) {
#pragma unroll
                for (int f = 0; f < 4; ++f) Kn[f] = *(const bf16x8*)(kcf + (size_t)((it + 1) * 4 + f) * 512); }
#pragma unroll
            for (int hd = 0; hd < 2; ++hd) { f32x16 S = zero16();
#pragma unroll
                for (int s = 0; s < 4; ++s) S = MFMA32(Kf[s], Qf[hd][s], S);
                float p[16];
#pragma unroll
                for (int i = 0; i < 16; ++i) { const int key = 32 * it + crow(i, h); p[i] = (key <= imq) ? fexp2(S[i] * c1 - c2) * inv[hd] : 0.f; }
                float bnd[4];
#pragma unroll
                for (int g4 = 0; g4 < 4; ++g4) bnd[g4] = __shfl_xor(p[4 * g4 + 3], 32);
#pragma unroll
                for (int g4 = 0; g4 < 4; ++g4) { const float G4 = (p[4 * g4] + p[4 * g4 + 1]) + (p[4 * g4 + 2] + p[4 * g4 + 3]);
                    const float extra = h ? bnd[g4] : (g4 ? bnd[g4 > 0 ? g4 - 1 : 0] : carry[hd]);
                    const int sblk = 8 * it + 2 * g4 + h; U[sblk * 32 + q] += G4 + extra; }
                carry[hd] = bnd[3]; }
        }
    }
    unsigned m0 = 0, m1 = 0, m2 = 0, m3 = 0;
    int tsel = tid; asm volatile("" : "+v"(tsel)); const int qsl = tsel & 31, hsl = (tsel >> 5) & 1;
#define SETBIT(idx) do { const int _i = (idx); const unsigned _b = 1u << (_i & 31); const int _w = _i >> 5; m0 |= (_w == 0) ? _b : 0u; m1 |= (_w == 1) ? _b : 0u; m2 |= (_w == 2) ? _b : 0u; m3 |= (_w == 3) ? _b : 0u; } while (0)
    if (cur <= 15) { m0 = (2u << cur) - 1u; }
    else {
        SETBIT(0); SETBIT(cur - 1); SETBIT(cur);
        const int mid = (cur + 1) >> 1; const int lo = hsl ? mid : 1, hi_ = hsl ? cur - 1 : mid;
#pragma unroll 1
        for (int r = 0; r < 13; ++r) {
            float bv = -2.f; int bi = 1 << 20;
#pragma unroll 8
            for (int s = lo; s < hi_; ++s) { const float v = U[s * 32 + qsl]; if (v > bv) { bv = v; bi = s; } }
            const float pv = __shfl_xor(bv, 32); const int pi = __shfl_xor(bi, 32);
            const bool takep = (pv > bv) || (pv == bv && pi < bi);
            const int wi = takep ? pi : bi;
            if (!takep) U[wi * 32 + qsl] = -1.f;
            SETBIT(wi);
        }
    }
#undef SETBIT
    const unsigned u0 = __builtin_amdgcn_readfirstlane(wave_or(m0)), u1 = __builtin_amdgcn_readfirstlane(wave_or(m1)), u2 = __builtin_amdgcn_readfirstlane(wave_or(m2)), u3 = __builtin_amdgcn_readfirstlane(wave_or(m3));
    if (lane == 0) { __hip_atomic_fetch_or((LAS unsigned*)&lc[LC_UNI + 0], u0, __ATOMIC_RELAXED, __HIP_MEMORY_SCOPE_WORKGROUP); __hip_atomic_fetch_or((LAS unsigned*)&lc[LC_UNI + 1], u1, __ATOMIC_RELAXED, __HIP_MEMORY_SCOPE_WORKGROUP);
        __hip_atomic_fetch_or((LAS unsigned*)&lc[LC_UNI + 2], u2, __ATOMIC_RELAXED, __HIP_MEMORY_SCOPE_WORKGROUP); __hip_atomic_fetch_or((LAS unsigned*)&lc[LC_UNI + 3], u3, __ATOMIC_RELAXED, __HIP_MEMORY_SCOPE_WORKGROUP); }
    __syncthreads();
    if (tid < 128) {
        const unsigned w0 = (unsigned)lc[LC_UNI + 0], w1 = (unsigned)lc[LC_UNI + 1], w2 = (unsigned)lc[LC_UNI + 2], w3 = (unsigned)lc[LC_UNI + 3];
        const int wd = tid >> 5, bit = tid & 31; const unsigned uw = (wd == 0) ? w0 : (wd == 1) ? w1 : (wd == 2) ? w2 : w3;
        const int below = (wd > 0 ? __builtin_popcount(w0) : 0) + (wd > 1 ? __builtin_popcount(w1) : 0) + (wd > 2 ? __builtin_popcount(w2) : 0) + __builtin_popcount(uw & ((1u << bit) - 1u));
        if ((uw >> bit) & 1u) lc[LC_BLIST + below] = tid;
        if (tid == 0) lc[LC_UNI + 4] = __builtin_popcount(w0) + __builtin_popcount(w1) + __builtin_popcount(w2) + __builtin_popcount(w3); }
    __syncthreads();
    const int nblk = __builtin_amdgcn_readfirstlane(lc[LC_UNI + 4]);
    { const int hd = hd_task;
        const int head = 2 * g + hd;
        int tl = tid; asm volatile("" : "+v"(tl));
        const int ql = tl & 31, hl = (tl >> 5) & 1; const size_t rowq2 = (size_t)b * T + t0 + ql;
        bf16x8 Qf[4]; ld_frag4(Qf, z + rowq2 * NZ + ZC_NQ + head * 64, hl);
        const float* glp = (const float*)(a.ws + WS_GL) + rowq2 * 12 + head * 3;
        const float gc = sigmoidf_(glp[0]), gs = sigmoidf_(glp[1]), gw = sigmoidf_(glp[2]);
        f32x16 F0, F1;
        {
            LAS float* slots = (LAS float*)lds;
            LAS int* cntj = (LAS int*)(lds + 69632);
            LAS int* ibj = (LAS int*)(lds + 70144);
            LAS unsigned char* qlist = lds + 70656;
            LAS unsigned short* tab = (LAS unsigned short*)(lds + 103424);
            LAS unsigned char* Qs = lds + 111616;
            if (tid < 128) cntj[tid] = 0;
#pragma unroll
            for (int sv = 0; sv < 4; ++sv) *(LAS bf16x8*)(Qs + (wave * 32 + ql) * 144 + (16 * sv + 8 * hl) * 2) = Qf[sv];
            __syncthreads();
            int ncon = 0;
            { const int qloc = wave * 32 + ql;
#pragma unroll 1
                for (int wd = 0; wd < 4; ++wd) { unsigned mm = (wd == 0) ? m0 : (wd == 1) ? m1 : (wd == 2) ? m2 : m3;
                    while (mm) { const int bit = __builtin_ctz(mm); mm &= mm - 1u; const int j = wd * 32 + bit;
                        if (hl == 0) { const int pos = __hip_atomic_fetch_add(&cntj[j], 1, __ATOMIC_RELAXED, __HIP_MEMORY_SCOPE_WORKGROUP); qlist[j * 256 + pos] = (unsigned char)qloc; tab[qloc * 16 + ncon] = (unsigned short)(j | (pos << 7)); }
                        ++ncon; } } }
            __syncthreads();
            {
                int ng = 0, jb = 0, cjb = 0;
                if (tid < 128 && tid < nblk) { jb = lc[LC_BLIST + tid]; cjb = cntj[jb]; ng = (cjb + 31) >> 5; }
                int incl = ng;
#pragma unroll
                for (int o = 1; o < 64; o <<= 1) { const int v = __shfl_up(incl, o); if ((tl & 63) >= o) incl += v; }
                if (tid == 63) lc[LC_UNI + 7] = incl;
                __syncthreads();
                if (tid < 128) { const int base = incl - ng + ((tid >= 64) ? lc[LC_UNI + 7] : 0);
                    if (tid < nblk) { ibj[jb] = base; for (int k = 0; k < ng; ++k) lc[LC_ITEMS + base + k] = jb | ((32 * k) << 8); }
                    if (tid == 127) lc[LC_UNI + 5] = base + ng; }
            }
            __syncthreads();
            const int nitems = __builtin_amdgcn_readfirstlane(lc[LC_UNI + 5]); const int lane6 = tl & 63; const int nrounds = (nitems + 7) >> 3;
            const bf16* kfb = (const bf16*)((unsigned char*)a.out + OB_KFSLC) + (size_t)(b * 2 + g) * T * 64 + (size_t)lane6 * 8;
            const bf16* vfb = (const bf16*)((unsigned char*)a.out + OB_VFSLC) + (size_t)(b * 2 + g) * T * 64 + (size_t)lane6 * 8;
#define NSA_LDT(ktg) do { _Pragma("unroll") for (int f_ = 0; f_ < 4; ++f_) { Kn[f_] = *(const bf16x8*)(kfb + (size_t)((ktg) * 4 + f_) * 512); Vn[f_] = *(const bf16x8*)(vfb + (size_t)((ktg) * 4 + f_) * 512); } } while (0)
            bf16x8 Kn[4], Vn[4];
            if (wave < nitems) { const int j0 = __builtin_amdgcn_readfirstlane(lc[LC_ITEMS + wave]) & 255; NSA_LDT(2 * j0); }
            int kcur = 0; float lacc = 0.f;
#pragma unroll
            for (int i = 0; i < 16; ++i) { F0[i] = 0.f; F1[i] = 0.f; }
            const int qown = wave * 32 + ql;
#pragma unroll 1
            for (int r = 0; r < nrounds; ++r) {
                const int it = 8 * r + wave;
                if (it < nitems) {
                    const int itm = __builtin_amdgcn_readfirstlane(lc[LC_ITEMS + it]); const int j = itm & 255, g0 = itm >> 8; const int cj = __builtin_amdgcn_readfirstlane(cntj[j]);
                    const int idx = g0 + ql; const bool valid = idx < cj; const int qloc = qlist[j * 256 + (valid ? idx : g0)];
                    const int tq = 256 * qs + qloc;
                    bf16x8 Qg[4];
#pragma unroll
                    for (int sv = 0; sv < 4; ++sv) Qg[sv] = *(const LAS bf16x8*)(Qs + qloc * 144 + (16 * sv + 8 * hl) * 2);
                    f32x16 O0 = zero16(), O1 = zero16(); float ls = 0.f;
#pragma unroll
                    for (int kt = 0; kt < 2; ++kt) { const int key0 = 64 * j + 32 * kt;
                        bf16x8 Kf[4], Vf[4];
#pragma unroll
                        for (int f = 0; f < 4; ++f) { Kf[f] = Kn[f]; Vf[f] = Vn[f]; }
                        if (kt == 0) { NSA_LDT(2 * j + 1); }
                        else if (it + 8 < nitems) { const int jn = __builtin_amdgcn_readfirstlane(lc[LC_ITEMS + it + 8]) & 255; NSA_LDT(2 * jn); }
                        f32x16 S = zero16();
#pragma unroll
                        for (int sv = 0; sv < 4; ++sv) S = MFMA32(Kf[sv], Qg[sv], S);
                        float p[16];
#pragma unroll
                        for (int i = 0; i < 16; ++i) { const int key = key0 + crow(i, hl); p[i] = (valid && key <= tq) ? fexp2(S[i] * c1 - c2) : 0.f; ls += p[i]; }
                        const bf16x8 P0 = pack8(p), P1 = pack8(p + 8);
                        O0 = MFMA32(Vf[0], P0, O0); O0 = MFMA32(Vf[1], P1, O0); O1 = MFMA32(Vf[2], P0, O1); O1 = MFMA32(Vf[3], P1, O1); }
                    ls += __shfl_xor(ls, 32);
                    LAS float* sl = slots + (wave * 32 + ql) * 68;
#pragma unroll
                    for (int g4 = 0; g4 < 4; ++g4) { *(LAS f32x4*)(sl + 8 * g4 + 4 * hl) = (f32x4){O0[4 * g4], O0[4 * g4 + 1], O0[4 * g4 + 2], O0[4 * g4 + 3]};
                        *(LAS f32x4*)(sl + 32 + 8 * g4 + 4 * hl) = (f32x4){O1[4 * g4], O1[4 * g4 + 1], O1[4 * g4 + 2], O1[4 * g4 + 3]}; }
                    if (hl == 0) sl[64] = ls;
                }
                __syncthreads();
                while (kcur < ncon) {
                    const int e = tab[qown * 16 + kcur]; const int j = e & 127, pos = e >> 7; const int item = ibj[j] + (pos >> 5);
                    if ((item >> 3) != r) break;
                    const LAS float* sl = slots + ((item & 7) * 32 + (pos & 31)) * 68;
#pragma unroll
                    for (int g4 = 0; g4 < 4; ++g4) { const f32x4 v0 = *(const LAS f32x4*)(sl + 8 * g4 + 4 * hl), v1 = *(const LAS f32x4*)(sl + 32 + 8 * g4 + 4 * hl);
#pragma unroll
                        for (int jj = 0; jj < 4; ++jj) { F0[4 * g4 + jj] += v0[jj]; F1[4 * g4 + jj] += v1[jj]; } }
                    lacc += sl[64]; ++kcur;
                }
                __syncthreads();
            }
#undef NSA_LDT
            { const float scl = gs / lacc; F0 = F0 * scl; F1 = F1 * scl; }
        }
        {
            f32x16 O0 = zero16(), O1 = zero16(); float ls = 0.f;
            bf16x8 Kn[4], Vn[4];
#pragma unroll
            for (int f = 0; f < 4; ++f) { Kn[f] = *(const bf16x8*)(kcf + (size_t)f * 512); Vn[f] = *(const bf16x8*)(vcf + (size_t)f * 512); }
#pragma unroll 1
            for (int it = 0; it < ntc; ++it) {
                bf16x8 Kf[4], Vf[4];
#pragma unroll
                for (int f = 0; f < 4; ++f) { Kf[f] = Kn[f]; Vf[f] = Vn[f]; }
                if (it + 1 < ntc) {
#pragma unroll
                    for (int f = 0; f < 4; ++f) { Kn[f] = *(const bf16x8*)(kcf + (size_t)((it + 1) * 4 + f) * 512); Vn[f] = *(const bf16x8*)(vcf + (size_t)((it + 1) * 4 + f) * 512); } }
                f32x16 S = zero16();
#pragma unroll
                for (int sv = 0; sv < 4; ++sv) S = MFMA32(Kf[sv], Qf[sv], S);
                float p[16];
                if (it < nfull_c) {
#pragma unroll
                    for (int i = 0; i < 16; ++i) { p[i] = fexp2(S[i] * c1 - c2); ls += p[i]; }
                } else {
#pragma unroll
                    for (int i = 0; i < 16; ++i) { const int key = 32 * it + crow(i, hl); p[i] = (key <= imq) ? fexp2(S[i] * c1 - c2) : 0.f; ls += p[i]; }
                }
                const bf16x8 P0 = pack8(p), P1 = pack8(p + 8);
                O0 = MFMA32(Vf[0], P0, O0); O0 = MFMA32(Vf[1], P1, O0); O1 = MFMA32(Vf[2], P0, O1); O1 = MFMA32(Vf[3], P1, O1);
            }
            ls += __shfl_xor(ls, 32); const float scl = (ls > 0.f) ? gc / ls : 0.f;
            F0 += O0 * scl; F1 += O1 * scl;
        }
        {
            f32x16 O0 = zero16(), O1 = zero16(); float ls = 0.f;
            const int lane6 = tl & 63;
            const bf16* kfw = (const bf16*)((unsigned char*)a.out + OB_KFWIN) + (size_t)(b * 2 + g) * T * 64 + (size_t)lane6 * 8;
            const bf16* vfw = (const bf16*)((unsigned char*)a.out + OB_VFWIN) + (size_t)(b * 2 + g) * T * 64 + (size_t)lane6 * 8;
            int ktw = qt - 16; if (ktw < 0) ktw = 0;
            bf16x8 Kn[4], Vn[4];
#pragma unroll
            for (int f = 0; f < 4; ++f) { Kn[f] = *(const bf16x8*)(kfw + (size_t)(ktw * 4 + f) * 512); Vn[f] = *(const bf16x8*)(vfw + (size_t)(ktw * 4 + f) * 512); }
#pragma unroll 1
            for (int kt = ktw; kt <= qt; ++kt) {
                bf16x8 Kf[4], Vf[4];
#pragma unroll
                for (int f = 0; f < 4; ++f) { Kf[f] = Kn[f]; Vf[f] = Vn[f]; }
                if (kt < qt) {
#pragma unroll
                    for (int f = 0; f < 4; ++f) { Kn[f] = *(const bf16x8*)(kfw + (size_t)((kt + 1) * 4 + f) * 512); Vn[f] = *(const bf16x8*)(vfw + (size_t)((kt + 1) * 4 + f) * 512); } }
                f32x16 S = zero16();
#pragma unroll
                for (int sv = 0; sv < 4; ++sv) S = MFMA32(Kf[sv], Qf[sv], S);
                float p[16];
                if (kt > qt - 16 && kt < qt) {
#pragma unroll
                    for (int i = 0; i < 16; ++i) { p[i] = fexp2(S[i] * c1 - c2); ls += p[i]; }
                } else {
#pragma unroll
                    for (int i = 0; i < 16; ++i) { const int key = 32 * kt + crow(i, hl); p[i] = (key <= t && key > t - 512) ? fexp2(S[i] * c1 - c2) : 0.f; ls += p[i]; }
                }
                const bf16x8 P0 = pack8(p), P1 = pack8(p + 8);
                O0 = MFMA32(Vf[0], P0, O0); O0 = MFMA32(Vf[1], P1, O0); O1 = MFMA32(Vf[2], P0, O1); O1 = MFMA32(Vf[3], P1, O1);
            }
            ls += __shfl_xor(ls, 32); const float scl = gw / ls;
            F0 += O0 * scl; F1 += O1 * scl;
        }
        bf16* yo = y + rowq2 * D + 768 + head * 64;
#pragma unroll
        for (int g4 = 0; g4 < 4; ++g4) { u32x2 w0, w1; w0.x = pk2(F0[4 * g4], F0[4 * g4 + 1]); w0.y = pk2(F0[4 * g4 + 2], F0[4 * g4 + 3]); w1.x = pk2(F1[4 * g4], F1[4 * g4 + 1]); w1.y = pk2(F1[4 * g4 + 2], F1[4 * g4 + 3]);
            *(u32x2*)(yo + 8 * g4 + 4 * h) = w0; *(u32x2*)(yo + 32 + 8 * g4 + 4 * h) = w1; }
    }
    __syncthreads();
}
constexpr int DEPTH = 2;
typedef const __attribute__((address_space(4))) Args* KArgsP;
__global__ void __launch_bounds__(512, 2) fwd_kernel(Args a_in) {
    extern __shared__ __attribute__((aligned(16))) unsigned char lds_raw[];
    LAS unsigned char* lds = (LAS unsigned char*)lds_raw;
    int tid = threadIdx.x, lane = tid & 63; const int wave = __builtin_amdgcn_readfirstlane(tid >> 6), G = gridDim.x;
    LAS int* lc = (LAS int*)(lds + LDSCTL_OFF);
#define PHASE() tid = threadIdx.x; asm volatile("" : "+v"(tid)); lane = tid & 63; KArgsP kp_ = (KArgsP)__builtin_amdgcn_kernarg_segment_ptr(); asm volatile("" : "+s"(kp_)); KArgsR a = *kp_; \
    gu32* ctl = (gu32*)(a.ws + WS_CTL); f16* h = (f16*)(a.ws + WS_H16); const float* modl = (const float*)(a.ws + WS_MOD) + l * 4 * 6144; (void)ctl; (void)modl; (void)h
#define GRID_BAR() do { KArgsP kb_ = (KArgsP)__builtin_amdgcn_kernarg_segment_ptr(); asm volatile("" : "+s"(kb_)); XcdBarrier b_; b_.bar = (unsigned*)(kb_->ws + WS_CTL) + CW_BAR; b_.x = xb_xcc_id(); \
        b_.st = (volatile LAS unsigned*)(lc + LC_BAR); xcd_barrier(b_); } while (0)
    for (int u = tid; u < (LDS_BYTES - LDSCTL_OFF) / 4; u += 512) lc[u] = 0;
    __syncthreads();
    { const int l = 0; PHASE(); (void)xcd_barrier_post((unsigned*)(a.ws + WS_CTL) + CW_BAR, (volatile LAS unsigned*)(lc + LC_BAR));
      prologue(a, lds, tid, lane, wave, G);
    }
    GRID_BAR();

    for (int l = 0; l < DEPTH; ++l) {
        const int dense = (l == 0);
        { PHASE();
          if (l == 0) norm_phase<12, false>(a, a.in[I_X], (const float*)a.in[I_NMG] + l * D, modl, 0, (const float*)a.in[I_WIN] + (size_t)l * D * NIN + NZ, NIN, lds, tid, lane, wave, G);
          else norm_phase<12, true>(a, h, (const float*)a.in[I_NMG] + l * D, modl, 0, (const float*)a.in[I_WIN] + (size_t)l * D * NIN + NZ, NIN, lds, tid, lane, wave, G); }
        GRID_BAR();
        { PHASE();
          pg8::Gemm g{(const bf16*)((unsigned char*)a.out + OB_A), (const bf16*)(a.ws + WS_WIN) + (size_t)l * NZ * D, M, NZ, D}; pg8::StaticOrder S; S.init(M, NZ, D, G, (int)blockIdx.x);
          EpiZ E{(bf16*)(a.ws + WS_Z)};
          pg8::gemm_phase<EpiZ, pg8::StaticOrder, true, false>(lds, g, S, E); }
        GRID_BAR();
        { PHASE(); for (int task = blockIdx.x; task < 256; task += G) cmp_task(a, l, task, lds, tid, lane, wave); }
        { PHASE(); for (int task = blockIdx.x; task < 512; task += G) s5_pass1(a, l, task >> 7, task & 127, lds, tid, lane, wave); }
        { PHASE(); for (int task = blockIdx.x; task < 512; task += G) { const int b = task >> 7, t0 = (task & 127) * 64; conv_tile(a, l, b, t0, tid); prep_tile(a, l, b, t0, lds, tid, lane, wave); } }
        GRID_BAR();
        { PHASE(); for (int bg = (int)blockIdx.x * 8 + wave; bg < 64; bg += G * 8) s5_carry(a, l, bg, lane, ctl + CW_S5F + 64 * l); }
        { PHASE(); for (int pr = blockIdx.x; pr < 256; pr += G) {
#pragma unroll 1
              for (int half = 0; half < 2; ++half) nsa_block(a, l, half ? (pr >> 4) : 31 - (pr >> 4), pr & 15, lds, lc, tid, lane, wave); } }
        { PHASE(); s5_carry_wait(ctl + CW_S5F + 64 * l, tid); for (int task = blockIdx.x; task < 512; task += G) s5_pass2(a, l, task >> 7, task & 127, lds, tid, lane, wave); }
        { PHASE(); for (int task = (int)blockIdx.x * 8 + wave; task < 4096; task += G * 8) sb_task(a, task, lane); }
        GRID_BAR();
        { PHASE();
          pg8::Gemm g{(const bf16*)(a.ws + WS_Y), (const bf16*)(a.ws + WS_WOUT) + (size_t)l * D * D, M, D, D}; pg8::StaticOrder S; S.init(M, D, D, G, (int)blockIdx.x);
          EpiRes E{l == 0 ? (const float*)a.in[I_X] : nullptr, h, modl};
          pg8::gemm_phase<EpiRes, pg8::StaticOrder, true, false>(lds, g, S, E); }
        GRID_BAR();
        { PHASE();
          if (dense) { norm_phase<0, true>(a, h, (const float*)a.in[I_NFG] + l * D, modl, 3072, nullptr, 0, lds, tid, lane, wave, G); }
          else { norm_phase<8, true>(a, h, (const float*)a.in[I_NFG] + l * D, modl, 3072, (const float*)a.in[I_MR], 8, lds, tid, lane, wave, G); } }
        GRID_BAR();
        const int npass = dense ? 1 : 2;
        for (int kp = 0; kp < npass; ++kp) {
            int nRT;
            { PHASE();
              if (tid == 0) {
                int rt = 0;
                if (dense) rt = 128;
                else for (int e = 0; e < 8; ++e) { const int c = (int)__hip_atomic_load(ctl + CW_CNT + (kp * 8 + e) * 64, RLX_AGENT); lc[LC_CNT + e] = c; const int nt_ = (c + 255) >> 8;
                    for (int i = 0; i < nt_; ++i) lc[LC_TILE + rt + i] = e | (i << 8); rt += nt_; }
                lc[LC_MISC] = rt;
              }
              __syncthreads();
              nRT = __builtin_amdgcn_readfirstlane(lc[LC_MISC]); }
            { PHASE(); const int* list = (const int*)(a.ws + WS_LIST) + (size_t)kp * 8 * 32768;
              pg8::Gemm g{(const bf16*)((unsigned char*)a.out + OB_A), dense ? (const bf16*)(a.ws + WS_WGUD) : (const bf16*)(a.ws + WS_WGUM), M, 7168, D};
              pg8::MoeOrder S; S.nRT = nRT; S.nN = 28; S.nwg = nRT * 28; S.G = G; S.c = (int)blockIdx.x; S.dense = dense; S.K2 = D * 2; S.tile_e = lc + LC_TILE; S.cnt = lc + LC_CNT; S.list = list; S.KT = D / 64; S.nfull = S.nwg; S.nsplit = 1;
              EpiSwiglu E{(bf16*)(a.ws + WS_HID)};
              pg8::gemm_phase<EpiSwiglu, pg8::MoeOrder, true, true>(lds, g, S, E); }
            GRID_BAR();
            int rem;
            { PHASE(); const int* list = (const int*)(a.ws + WS_LIST) + (size_t)kp * 8 * 32768;
              pg8::Gemm g{(const bf16*)(a.ws + WS_HID), dense ? (const bf16*)(a.ws + WS_WDD) : (const bf16*)(a.ws + WS_WDM), M, D, FF};
              pg8::MoeOrder S; S.nRT = nRT; S.nN = 4; S.nwg = nRT * 4; S.G = G; S.c = (int)blockIdx.x; S.dense = dense; S.K2 = FF * 2; S.tile_e = lc + LC_TILE; S.cnt = lc + LC_CNT; S.list = list;
              S.KT = FF / 64; S.nfull = (S.nwg / G) * G; S.nsplit = 7; rem = S.nwg - S.nfull; if (rem > 32) { S.nfull = S.nwg; rem = 0; }
              EpiDown E{h, a.out, modl, list, (const float*)(a.ws + WS_RTW), lc + LC_CNT, dense, kp, (l == DEPTH - 1 && kp == npass - 1) ? 1 : 0, (float*)(a.ws + WS_PART)};
              pg8::gemm_phase<EpiDown, pg8::MoeOrder, true, false>(lds, g, S, E); }
            if (rem > 0) {
                GRID_BAR();
                { PHASE(); const int* list = (const int*)(a.ws + WS_LIST) + (size_t)kp * 8 * 32768; const float* part = (const float*)(a.ws + WS_PART); const float* rtw = (const float*)(a.ws + WS_RTW);
                  pg8::MoeOrder S; S.nRT = nRT; S.nN = 4; S.nwg = nRT * 4; S.G = G; S.c = 0; S.dense = dense; S.K2 = 0; S.tile_e = lc + LC_TILE; S.cnt = lc + LC_CNT; S.list = list; S.KT = FF / 64; S.nfull = (S.nwg / G) * G; S.nsplit = 7;
                  for (int w = blockIdx.x * 8 + wave; w < rem * 256; w += G * 8) { const int ui = w >> 8, r = w & 255; pg8::Unit u; S.decode(S.nfull + ui, u);
                      const int idx = u.lt * 256 + r; int tok = idx; float wgt = 1.f; bool ok = true;
                      if (!dense) { ok = idx < lc[LC_CNT + u.e]; tok = ok ? list[u.e * 32768 + idx] : 0; wgt = ok ? rtw[tok * 2 + kp] : 0.f; }
                      if (ok) { f32x4 sum = (f32x4){0.f, 0.f, 0.f, 0.f};
#pragma unroll
                          for (int sp = 0; sp < 7; ++sp) sum += *(const f32x4*)(part + (size_t)(ui * 7 + sp) * 65536 + r * 256 + 4 * lane);
                          const int col = u.pl * 256 + 4 * lane; const int bb = tok >> 13; const f32x4 gv = *(const f32x4*)(modl + bb * 6144 + 5120 + col);
                          f16* hp = h + (size_t)tok * D + col; const u32x2 t = *(const u32x2*)hp; const f32x4 o = h4(t.x, t.y) + (gv * wgt) * sum;
                          if (l == DEPTH - 1 && kp == npass - 1) *(f32x4*)(a.out + (size_t)tok * D + col) = o; else { u32x2 wv; wv.x = pkh(o.x, o.y); wv.y = pkh(o.z, o.w); *(u32x2*)hp = wv; } } } }
            }
            GRID_BAR();
        }
    }
}

extern "C" void kernel_launch(void* const* d_in, const int* in_sizes, int n_in, void* d_out, int out_size, void* d_ws, size_t ws_size, hipStream_t stream) {
    static int grid = 0;
    if (grid == 0) {
        if (n_in != 34 || in_sizes[0] != M * D || out_size != M * D || ws_size < WS_END) { fprintf(stderr, "kernel_launch: unexpected shapes: n_in %d in0 %d out %d ws %zu (need %zu)\n", n_in, n_in > 0 ? in_sizes[0] : -1, out_size, ws_size, (size_t)WS_END); grid = -1; return; }
        int dev = 0, cus = 0, per_cu = 0;
        if (hipGetDevice(&dev) != hipSuccess || hipDeviceGetAttribute(&cus, hipDeviceAttributeMultiprocessorCount, dev) != hipSuccess) { grid = -1; return; }
        if (hipFuncSetAttribute((const void*)fwd_kernel, hipFuncAttributeMaxDynamicSharedMemorySize, LDS_BYTES) != hipSuccess) { fprintf(stderr, "kernel_launch: hipFuncSetAttribute failed\n"); grid = -1; return; }
        if (hipOccupancyMaxActiveBlocksPerMultiprocessor(&per_cu, (const void*)fwd_kernel, 512, LDS_BYTES) != hipSuccess || per_cu < 1) { fprintf(stderr, "kernel_launch: occupancy query says %d blocks per CU\n", per_cu); (void)hipGetLastError(); grid = -1; return; }
        grid = cus;
    }
    if (grid < 0) return;
    if (hipMemsetAsync((char*)d_ws + WS_CTL, 0, CTL_ZERO_BYTES, stream) != hipSuccess) return;
    Args a{};
    for (int i = 0; i < 34; ++i) a.in[i] = d_in[i];
    a.out = (float*)d_out; a.ws = (unsigned char*)d_ws;
    hipLaunchKernelGGL(fwd_kernel, dim3(grid), dim3(512), LDS_BYTES, stream, a);
}
```

```cpp
#define NORM_PF 1
#include <hip/hip_runtime.h>
#include <cstdio>
#include <cstdint>

#define LAS __attribute__((address_space(3)))
#define GAS __attribute__((address_space(1)))
typedef unsigned short bf16;
typedef short bf16x8 __attribute__((ext_vector_type(8)));
typedef short s16x4 __attribute__((ext_vector_type(4)));
typedef float f32x2 __attribute__((ext_vector_type(2)));
typedef float f32x4 __attribute__((ext_vector_type(4)));
typedef float f32x16 __attribute__((ext_vector_type(16)));
typedef unsigned u32x2 __attribute__((ext_vector_type(2)));
typedef unsigned u32x4 __attribute__((ext_vector_type(4)));
typedef __bf16 bf16x2_t __attribute__((ext_vector_type(2)));
typedef GAS unsigned gu32;
#define RLX_AGENT __ATOMIC_RELAXED, __HIP_MEMORY_SCOPE_AGENT
#define DI __device__ __forceinline__

constexpr int NB = 4, T = 8192, M = NB * T, D = 1024, NIN = 2828, NZ = 2816, FF = 3584, NE = 8;
constexpr int NC = 511;
constexpr int ZC_CB = 0, ZC_CC = 256, ZC_CU = 512, ZC_SSM = 768, ZC_SBQ = 1024, ZC_SBK = 1280, ZC_SBV = 1536, ZC_NQ = 1792, ZC_KV = 2048;
constexpr float RMS_EPS = 1e-6f;

DI unsigned f2bf(float f) { unsigned u = __builtin_bit_cast(unsigned, f); return (u + 0x7fffu + ((u >> 16) & 1u)) >> 16; }
DI unsigned pk2(float lo, float hi) { f32x2 v = {lo, hi}; bf16x2_t b = __builtin_convertvector(v, bf16x2_t); return __builtin_bit_cast(unsigned, b); }
DI float bf2f(unsigned b) { return __builtin_bit_cast(float, b << 16); }
DI float bflo(unsigned w) { return __builtin_bit_cast(float, w << 16); }
DI float bfhi(unsigned w) { return __builtin_bit_cast(float, w & 0xffff0000u); }
#define WR_DPP(v, ctrl) __builtin_bit_cast(float, __builtin_amdgcn_update_dpp(0, __builtin_bit_cast(int, (v)), (ctrl), 0xf, 0xf, true))
DI float wave_sum(float v) {
    v += WR_DPP(v, 0xB1); v += WR_DPP(v, 0x4E); v += WR_DPP(v, 0x141); v += WR_DPP(v, 0x140);
    const int b = __builtin_bit_cast(int, v);
    return (__builtin_bit_cast(float, __builtin_amdgcn_readlane(b, 0)) + __builtin_bit_cast(float, __builtin_amdgcn_readlane(b, 16))) + (__builtin_bit_cast(float, __builtin_amdgcn_readlane(b, 32)) + __builtin_bit_cast(float, __builtin_amdgcn_readlane(b, 48)));
}
DI float wave_max(float v) {
    v = fmaxf(v, WR_DPP(v, 0xB1)); v = fmaxf(v, WR_DPP(v, 0x4E)); v = fmaxf(v, WR_DPP(v, 0x141)); v = fmaxf(v, WR_DPP(v, 0x140));
    const int b = __builtin_bit_cast(int, v);
    return fmaxf(fmaxf(__builtin_bit_cast(float, __builtin_amdgcn_readlane(b, 0)), __builtin_bit_cast(float, __builtin_amdgcn_readlane(b, 16))), fmaxf(__builtin_bit_cast(float, __builtin_amdgcn_readlane(b, 32)), __builtin_bit_cast(float, __builtin_amdgcn_readlane(b, 48))));
}

namespace pg8 {
constexpr int BM = 256, BK = 64, HALF = 128, HTB = HALF * BK * 2, STAGE_BYTES = 8 * HTB, NXCD = 8, WGM = 8;
__host__ __device__ __forceinline__ int lds_byte(int r, int c) { const int st = (r >> 4) * 2 + (c >> 5), rr = r & 15, cc = c & 31, ob = rr * 64 + cc * 2; return st * 1024 + (ob ^ (((ob >> 9) & 1) << 5)); }
__host__ __device__ __forceinline__ void stage_rc(int b, int& R, int& C) { const int st = b / 1024, sb = b % 1024, swz = sb ^ (((sb >> 9) & 1) << 5); R = (st >> 1) * 16 + swz / 64; C = (st & 1) * 32 + (swz % 64) / 2; }
__host__ __device__ __forceinline__ int perm32(int rho) { const int n = rho >> 4, i = rho & 15; return 8 * (i >> 2) + 4 * n + (i & 3); }

struct Unit { int pm, pn, e, lt, pl, kt0, nkt, part; };
struct Gemm { const bf16* A; const bf16* Bt; int M, N, K; };

struct StaticOrder {
    int nM, nN, nwg, G, c, KT;
    __device__ void init(int M_, int N_, int K_, int G_, int c_) { nM = M_ / BM; nN = N_ / BM; nwg = nM * nN; G = G_; c = c_; KT = K_ / BK; }
    __device__ bool next(int i, Unit& u) const {
        const long L = (long)i * G + c; if (L >= nwg) return false;
        int wgid = (int)L; { const int q = nwg / NXCD, r = nwg % NXCD, xcd = wgid % NXCD, off = wgid / NXCD; wgid = (xcd < r ? xcd * (q + 1) : r * (q + 1) + (xcd - r) * q) + off; }
        const int nig = WGM * nN, gid = wgid / nig, fm = gid * WGM, gsz = (nM - fm) < WGM ? (nM - fm) : WGM;
        u.pm = fm + ((wgid % nig) % gsz); u.pn = (wgid % nig) / gsz; u.e = 0; u.lt = u.pm; u.pl = u.pn; u.kt0 = 0; u.nkt = KT; u.part = -1; return true;
    }
    __device__ __forceinline__ unsigned row_off(const Unit&, int) const { return 0u; }
};

struct MoeOrder {
    int nRT, nN, nwg, G, c, dense, K2;
    int KT, nfull, nsplit;
    const LAS int* tile_e; const LAS int* cnt; const int* list;
    __device__ bool next(int i, Unit& u) const {
        const long L = (long)i * G + c; int unit;
        if (L < nfull) { unit = (int)L; u.kt0 = 0; u.nkt = KT; u.part = -1; }
        else { const long s = L - nfull; if (s >= (long)(nwg - nfull) * nsplit) return false; unit = nfull + (int)(s / nsplit); const int sp = (int)(s % nsplit); u.nkt = KT / nsplit; u.kt0 = sp * u.nkt; u.part = (int)s; }
        decode(unit, u); return true;
    }
    __device__ void decode(int unit, Unit& u) const {
        int wgid = unit; { const int q = nwg / NXCD, r = nwg % NXCD, xcd = wgid % NXCD, off = wgid / NXCD; wgid = (xcd < r ? xcd * (q + 1) : r * (q + 1) + (xcd - r) * q) + off; }
        const int nig = WGM * nN, gid = wgid / nig, fm = gid * WGM, gsz = (nRT - fm) < WGM ? (nRT - fm) : WGM;
        u.pm = fm + ((wgid % nig) % gsz); u.pl = (wgid % nig) / gsz;
        const int te = dense ? (u.pm << 8) : __builtin_amdgcn_readfirstlane(tile_e[u.pm]); u.e = te & 255; u.lt = te >> 8; u.pn = u.e * nN + u.pl;
    }
    __device__ __forceinline__ unsigned row_off(const Unit& u, int r) const {
        const int idx = u.lt * 256 + r; int tok;
        if (dense) tok = idx; else tok = (idx < cnt[u.e]) ? list[u.e * 32768 + idx] : 0;
        return (unsigned)tok * (unsigned)K2;
    }
};

template <class Epi, class Sched, bool ALIGN_EPI, bool GATHER>
__device__ __forceinline__ void gemm_phase(LAS unsigned char* lds, const Gemm g, const Sched& S, const Epi& E) {
    int tid_l = threadIdx.x; asm volatile("" : "+v"(tid_l));
    const int tid = tid_l, wid = __builtin_amdgcn_readfirstlane(tid >> 6), lane = tid & 63, wr = wid >> 2, wc = wid & 3, fr = lane & 15, fq = lane >> 4;
    const int K = g.K;
    unsigned voffA[2], voffB[2]; int RA[2]; unsigned CA2[2];
#pragma unroll
    for (int i = 0; i < 2; ++i) { int R, C; stage_rc(tid * 16 + i * 8192, R, C); const int Rb = Epi::PERM ? ((R & ~31) + perm32(R & 31)) : R;
        voffA[i] = (unsigned)(R * K + C) * 2u; voffB[i] = (unsigned)(Rb * K + C) * 2u; RA[i] = R; CA2[i] = (unsigned)C * 2u; }
    const size_t kstep = (size_t)(BK * 2);
    const size_t hstep = (size_t)HALF * K * 2;
    const size_t tstep = 2 * hstep;
    const unsigned ldsw = (unsigned)wid * 1024u;
    const int aoff = lds_byte(wr * 64 + fr, fq * 8), boff = lds_byte(wc * 32 + fr, fq * 8);
#define PG8_SA(b, h) (((b) * 2 + (h)) * HTB)
#define PG8_SB(b, h) ((4 + (b) * 2 + (h)) * HTB)
#define PG8_STAGE(bufoff, gbase, voff) do { _Pragma("unroll") for (int _i = 0; _i < 2; ++_i) \
        __builtin_amdgcn_global_load_lds((const unsigned*)((const char*)(gbase) + (voff)[_i]), (LAS unsigned*)(lds + (bufoff) + ldsw + _i * 8192), 16, 0, 0); } while (0)
#define PG8_STAGE_A(b, h, gbase, vg) do { if constexpr (GATHER) { PG8_STAGE(PG8_SA(b, h), gbase, (vg)[h]); } else { PG8_STAGE(PG8_SA(b, h), (gbase) + (h) * hstep, voffA); } } while (0)
#define PG8_LDA(dst, b, h) do { _Pragma("unroll") for (int m = 0; m < 4; ++m) _Pragma("unroll") for (int k = 0; k < 2; ++k) dst[m][k] = *(const LAS bf16x8*)(lds + PG8_SA(b, h) + aoff + m * 2048 + k * 1024); } while (0)
#define PG8_LDB(dst, b, h) do { _Pragma("unroll") for (int n = 0; n < 2; ++n) _Pragma("unroll") for (int k = 0; k < 2; ++k) dst[n][k] = *(const LAS bf16x8*)(lds + PG8_SB(b, h) + boff + n * 2048 + k * 1024); } while (0)
#define PG8_MMA(ai, bj, At, Bt) do { __builtin_amdgcn_s_setprio(1); _Pragma("unroll") for (int m = 0; m < 4; ++m) _Pragma("unroll") for (int n = 0; n < 2; ++n) _Pragma("unroll") for (int k = 0; k < 2; ++k) \
        acc[ai][bj][m][n] = __builtin_amdgcn_mfma_f32_16x16x32_bf16(Bt[n][k], At[m][k], acc[ai][bj][m][n], 0, 0, 0); __builtin_amdgcn_s_setprio(0); } while (0)
#define PG8_WAIT_V(n) asm volatile("s_waitcnt vmcnt(" #n ")" ::: "memory")
#define PG8_WAIT_L(n) asm volatile("s_waitcnt lgkmcnt(" #n ")" ::: "memory")
#define PG8_BAR __builtin_amdgcn_s_barrier()
#define PG8_SCHED __builtin_amdgcn_sched_barrier(0)
    Unit cur, nxt; int ui = 0;
    if (!S.next(0, cur)) return;
    f32x4 acc[2][2][4][2];
#pragma unroll
    for (int a = 0; a < 2; ++a)
#pragma unroll
        for (int b = 0; b < 2; ++b)
#pragma unroll
            for (int m = 0; m < 4; ++m)
#pragma unroll
                for (int n = 0; n < 2; ++n) acc[a][b][m][n] = (f32x4){0.f, 0.f, 0.f, 0.f};
    bf16x8 At[4][2], B0[2][2], B1[2][2];
    unsigned vgc[2][2], vgn[2][2];
    const char* cA = (GATHER ? (const char*)g.A : (const char*)g.A + (size_t)cur.pm * tstep) + (size_t)cur.kt0 * kstep; const char* cB = (const char*)g.Bt + (size_t)cur.pn * tstep + (size_t)cur.kt0 * kstep;
    if constexpr (GATHER) {
#pragma unroll
        for (int h = 0; h < 2; ++h)
#pragma unroll
            for (int i = 0; i < 2; ++i) { vgc[h][i] = S.row_off(cur, h * HALF + RA[i]) + CA2[i]; vgn[h][i] = vgc[h][i]; }
    }
    PG8_STAGE(PG8_SB(0, 0), cB, voffB); PG8_STAGE(PG8_SB(0, 1), cB + hstep, voffB); PG8_STAGE_A(0, 0, cA, vgc); PG8_STAGE_A(0, 1, cA, vgc);
    if (wr == 1) PG8_BAR;
    PG8_WAIT_V(2); PG8_BAR;
    PG8_STAGE(PG8_SB(1, 0), cB + kstep, voffB); PG8_STAGE_A(1, 0, cA + kstep, vgc); PG8_STAGE(PG8_SB(1, 1), cB + hstep + kstep, voffB);
    PG8_WAIT_V(6); PG8_BAR;
    for (;;) {
        const bool has_next = S.next(ui + 1, nxt);
        const char* nA = has_next ? (GATHER ? (const char*)g.A : (const char*)g.A + (size_t)nxt.pm * tstep) + (size_t)nxt.kt0 * kstep : cA; const char* nB = has_next ? (const char*)g.Bt + (size_t)nxt.pn * tstep + (size_t)nxt.kt0 * kstep : cB;
        const int nt = cur.nkt;
        if constexpr (GATHER) {
            if (has_next) {
#pragma unroll
                for (int h = 0; h < 2; ++h)
#pragma unroll
                    for (int i = 0; i < 2; ++i) vgn[h][i] = S.row_off(nxt, h * HALF + RA[i]) + CA2[i];
            }
        }
        for (int t = 0; t < nt; t += 2) {
            const bool last = (t == nt - 2);
            const char* a1 = cA + (size_t)(t + 1) * kstep;
            const char* a2 = last ? nA : cA + (size_t)(t + 2) * kstep; const char* b2 = last ? nB : cB + (size_t)(t + 2) * kstep;
            const char* a3 = a2 + kstep; const char* b3 = b2 + kstep;
            unsigned vg2[2][2];
            if constexpr (GATHER) {
#pragma unroll
                for (int h = 0; h < 2; ++h)
#pragma unroll
                    for (int i = 0; i < 2; ++i) vg2[h][i] = last ? vgn[h][i] : vgc[h][i];
            }
            PG8_LDB(B0, 0, 0); PG8_LDB(B1, 0, 1); PG8_SCHED; PG8_LDA(At, 0, 0); PG8_STAGE_A(1, 1, a1, vgc);
            PG8_WAIT_V(8); PG8_WAIT_L(0); PG8_BAR; PG8_MMA(0, 0, At, B0); PG8_MMA(0, 1, At, B1); PG8_BAR; PG8_SCHED;
            PG8_LDA(At, 0, 1); PG8_STAGE(PG8_SB(0, 0), b2, voffB); PG8_STAGE(PG8_SB(0, 1), b2 + hstep, voffB); PG8_STAGE_A(0, 0, a2, vg2);
            PG8_WAIT_V(8); PG8_WAIT_L(0); PG8_BAR; PG8_MMA(1, 0, At, B0); PG8_MMA(1, 1, At, B1); PG8_BAR; PG8_SCHED;
            PG8_LDB(B0, 1, 0); PG8_LDB(B1, 1, 1); PG8_SCHED; PG8_LDA(At, 1, 0); PG8_STAGE_A(0, 1, a2, vg2);
            PG8_WAIT_V(8); PG8_WAIT_L(0); PG8_BAR; PG8_MMA(0, 0, At, B0); PG8_MMA(0, 1, At, B1); PG8_BAR; PG8_SCHED;
            PG8_LDA(At, 1, 1); PG8_STAGE(PG8_SB(1, 0), b3, voffB); PG8_STAGE(PG8_SB(1, 1), b3 + hstep, voffB); PG8_STAGE_A(1, 0, a3, vg2);
            PG8_WAIT_V(8); PG8_WAIT_L(0); PG8_BAR; PG8_MMA(1, 0, At, B0); PG8_MMA(1, 1, At, B1); PG8_BAR; PG8_SCHED;
        }
        if constexpr (ALIGN_EPI) { if (wr == 0) PG8_BAR; }
        E(acc, cur, wr, wc, fr, fq);
        if (!has_next) break;
#pragma unroll
        for (int a = 0; a < 2; ++a)
#pragma unroll
            for (int b = 0; b < 2; ++b)
#pragma unroll
                for (int m = 0; m < 4; ++m)
#pragma unroll
                    for (int n = 0; n < 2; ++n) acc[a][b][m][n] = (f32x4){0.f, 0.f, 0.f, 0.f};
        cur = nxt; cA = nA; cB = nB; ++ui;
        if constexpr (GATHER) {
#pragma unroll
            for (int h = 0; h < 2; ++h)
#pragma unroll
                for (int i = 0; i < 2; ++i) vgc[h][i] = vgn[h][i];
        }
        if constexpr (ALIGN_EPI) { if (wr == 1) PG8_BAR; }
    }
    PG8_WAIT_V(0);
    if constexpr (!ALIGN_EPI) { if (wr == 0) PG8_BAR; }
    PG8_BAR;
#undef PG8_SA
#undef PG8_SB
#undef PG8_STAGE
#undef PG8_STAGE_A
#undef PG8_LDA
#undef PG8_LDB
#undef PG8_MMA
#undef PG8_WAIT_V
#undef PG8_WAIT_L
#undef PG8_BAR
#undef PG8_SCHED
}
}
#define XB_TMO      128
#define XB_XCNT(j)  (256  + 64 * (j))
#define XB_XSUB(j)  (1280 + 64 * (j))
#define XB_XGEN(j)  (2304 + 64 * (j))
#define XB_TOP      3328
#define XB_TOPGEN   3392
#define XCD_BAR_WORDS 3456
#define XB_SPIN_CAP (1u << 18)

__device__ __forceinline__ unsigned xb_ld(unsigned* p)              { return __hip_atomic_load(p, __ATOMIC_RELAXED, __HIP_MEMORY_SCOPE_AGENT); }
__device__ __forceinline__ unsigned xb_add(unsigned* p, unsigned v) { return __hip_atomic_fetch_add(p, v, __ATOMIC_RELAXED, __HIP_MEMORY_SCOPE_AGENT); }
__device__ __forceinline__ unsigned xb_xcc_id() { return (unsigned)__builtin_amdgcn_s_getreg((3 << 11) | 20) & 0xFu; }
#define XB_SPIN(cond, bar) do { unsigned _sp = 0; while (cond) { __builtin_amdgcn_s_sleep(1); \
    if ((++_sp & 255u) == 0u) { if (xb_ld(&(bar)[XB_TMO])) break; if (_sp > XB_SPIN_CAP) { atomicAdd(&(bar)[XB_TMO], 1u); break; } } } } while (0)

struct XcdBarrier {
    unsigned* bar; unsigned x;
    volatile LAS unsigned* st;
};

__device__ __forceinline__ XcdBarrier xcd_barrier_post(unsigned* bar, volatile LAS unsigned* st) {
    XcdBarrier b; b.bar = bar; b.x = xb_xcc_id(); b.st = st;
    if (threadIdx.x == 0) (void)xb_add(&bar[XB_XCNT(b.x)], 1u);
    return b;
}
__device__ __forceinline__ void xcd_barrier_complete(unsigned* bar, unsigned x, unsigned& nloc, unsigned& nx) {
    const unsigned G = gridDim.x * gridDim.y * gridDim.z;
    unsigned sum, cnt, mine, sp = 0u;
    for (;;) {
        sum = 0u; cnt = 0u; mine = 0u;
#pragma unroll
        for (unsigned j = 0; j < 16; ++j) { const unsigned c = xb_ld(&bar[XB_XCNT(j)]); sum += c; cnt += (c > 0u) ? 1u : 0u; mine = (j == x) ? c : mine; }
        if (sum == G) break;
        __builtin_amdgcn_s_sleep(1);
        if ((++sp & 255u) == 0u) { if (xb_ld(&bar[XB_TMO])) break; if (sp > XB_SPIN_CAP) { atomicAdd(&bar[XB_TMO], 1u); break; } }
    }
    nloc = mine > 0u ? mine : 1u; nx = cnt > 0u ? cnt : 1u;
}

__device__ __forceinline__ void xcd_barrier(const XcdBarrier& b) {
    asm volatile("s_waitcnt vmcnt(0)" ::: "memory");
    __syncthreads();
    if (threadIdx.x == 0) {
        unsigned* bar = b.bar;
        __builtin_amdgcn_s_waitcnt(0);
        unsigned nloc = b.st[0], nx = b.st[1];
        if (nloc == 0u) { xcd_barrier_complete(bar, b.x, nloc, nx); b.st[0] = nloc; b.st[1] = nx; }
        const unsigned old = xb_add(&bar[XB_XSUB(b.x)], 1u);
        const unsigned gen = old / nloc;
        if (old + 1u == (gen + 1u) * nloc) {
            __builtin_amdgcn_fence(__ATOMIC_RELEASE, "agent");
            asm volatile("s_waitcnt vmcnt(0)" ::: "memory");
            const unsigned og = xb_add(&bar[XB_TOP], 1u);
            const unsigned tg = og / nx;
            if (og + 1u == (tg + 1u) * nx) xb_add(&bar[XB_TOPGEN], 1u);
            else XB_SPIN(xb_ld(&bar[XB_TOPGEN]) == tg, bar);
            __builtin_amdgcn_fence(__ATOMIC_ACQUIRE, "agent");
            xb_add(&bar[XB_XGEN(b.x)], 1u);
            asm volatile("s_waitcnt vmcnt(0)" ::: "memory");
        } else {
            XB_SPIN(xb_ld(&bar[XB_XGEN(b.x)]) == gen, bar);
            __builtin_amdgcn_fence(__ATOMIC_ACQUIRE, "agent");
            asm volatile("s_waitcnt vmcnt(0)" ::: "memory");
        }
    }
    __syncthreads();
}

constexpr size_t MiB = 1u << 20;
constexpr size_t WS_CTL = 0, CTL_ZERO_BYTES = 1 * MiB;
constexpr size_t WS_MOD = 1 * MiB;
constexpr size_t WS_CBIAS = WS_MOD + 256 * 1024;
constexpr size_t WS_GL = 2 * MiB;
constexpr size_t WS_RTW = 4 * MiB;
constexpr size_t WS_LIST = 5 * MiB;
constexpr size_t WS_S5E = 7 * MiB;
constexpr size_t WS_S5C = 12 * MiB;
constexpr size_t WS_KC = 11 * MiB;
constexpr size_t WS_VCT = WS_KC + 512 * 1024;
constexpr size_t WS_WIN = 16 * MiB;
constexpr size_t WS_WOUT = 27 * MiB;
constexpr size_t WS_WGUD = 31 * MiB;
constexpr size_t WS_WDD = 45 * MiB;
constexpr size_t WS_WGUM = 52 * MiB;
constexpr size_t WS_WDM = 164 * MiB;
constexpr size_t WS_CW1 = 220 * MiB;
constexpr size_t WS_CW2 = 224 * MiB;
constexpr size_t WS_WGLU = WS_CW2 + 512 * 1024;
constexpr size_t WS_H16 = 226 * MiB;
constexpr size_t OB_A = 0, OB_KFSB = 0 * MiB, OB_VFSB = 16 * MiB, OB_KFSLC = 32 * MiB, OB_VFSLC = 40 * MiB, OB_KFWIN = 48 * MiB, OB_VFWIN = 56 * MiB;
constexpr size_t WS_Z = 290 * MiB;
constexpr size_t WS_Y = 466 * MiB;
constexpr size_t WS_HID = 290 * MiB;
constexpr size_t WS_PART = 530 * MiB;
constexpr size_t WS_END = 586 * MiB;
static_assert(WS_HID + (size_t)34816 * FF * 2 <= WS_PART && WS_PART + (size_t)224 * 65536 * 4 <= WS_END && WS_Z + (size_t)M * NZ * 2 <= WS_Y && WS_Y + (size_t)M * D * 2 <= WS_END, "ws map");
static_assert(WS_WDM + (size_t)8 * 1024 * FF * 2 <= WS_CW1 && WS_WGUM + (size_t)8 * 7168 * 1024 * 2 <= WS_WDM && WS_WIN + (size_t)2 * NZ * D * 2 <= WS_WOUT, "ws map 2");
constexpr int CW_BAR = 4096, CW_CNT = 8192  , CW_Q = 12288  , CW_S5F = 13312  ;

constexpr int RING_BYTES = 131072, NSA_STG_OFF = RING_BYTES  , LDSCTL_OFF = RING_BYTES + 20480, LDS_BYTES = LDSCTL_OFF + 4096;
constexpr int LC_MISC = 0, LC_BAR = 8, LC_CNT = 16, LC_TILE = 32, LC_BASE = 200  , LC_LCNT = 216  , LC_UNI = 232  , LC_BLIST = 256  , LC_ITEMS = 384  ;

#ifndef NORM_PF
#define NORM_PF 4
#endif
#define LDS_WAIT() asm volatile("s_waitcnt lgkmcnt(0)" ::: "memory")
#define VM_WAIT() asm volatile("s_waitcnt vmcnt(0)" ::: "memory")
constexpr float LOG2E = 1.4426950408889634f, LN2 = 0.6931471805599453f;

DI float fexp2(float x) { return __builtin_amdgcn_exp2f(x); }
DI float fexp(float x) { return __builtin_amdgcn_exp2f(x * LOG2E); }
DI float sigmoidf_(float x) { return __builtin_amdgcn_rcpf(1.f + fexp(-x)); }
DI float siluf_(float x) { return x * sigmoidf_(x); }
DI float gelu_tanh(float x) { const float u = 0.7978845608028654f * (x + 0.044715f * x * x * x); const float th = 1.f - 2.f * __builtin_amdgcn_rcpf(fexp(2.f * u) + 1.f); return 0.5f * x * (1.f + th); }
typedef _Float16 f16; typedef _Float16 f16x2_t __attribute__((ext_vector_type(2)));
DI unsigned pkh(float lo, float hi) { f16x2_t v = {(f16)__builtin_amdgcn_fmed3f(lo, -65504.f, 65504.f), (f16)__builtin_amdgcn_fmed3f(hi, -65504.f, 65504.f)}; return __builtin_bit_cast(unsigned, v); }
DI f32x4 h4(unsigned a, unsigned b) { const f16x2_t x = __builtin_bit_cast(f16x2_t, a), y = __builtin_bit_cast(f16x2_t, b); return (f32x4){(float)x[0], (float)x[1], (float)y[0], (float)y[1]}; }
DI int crow(int r, int hi) { return (r & 3) + 8 * (r >> 2) + 4 * hi; }

struct EpiZ {
    static constexpr bool PERM = true;
    bf16* O;
    DI void operator()(const f32x4 (&acc)[2][2][4][2], const pg8::Unit& u, int wr, int wc, int fr, int fq) const {
        const int row0 = u.pm * 256 + wr * 64 + fr, col0 = u.pn * 256 + wc * 32 + 8 * fq;
#pragma unroll
        for (int ai = 0; ai < 2; ++ai)
#pragma unroll
            for (int m = 0; m < 4; ++m) { bf16* rowp = O + (size_t)(row0 + ai * 128 + m * 16) * NZ + col0;
#pragma unroll
                for (int bj = 0; bj < 2; ++bj) { const f32x4 v0 = acc[ai][bj][m][0], v1 = acc[ai][bj][m][1];
                    u32x4 w; w.x = pk2(v0[0], v0[1]); w.y = pk2(v0[2], v0[3]); w.z = pk2(v1[0], v1[1]); w.w = pk2(v1[2], v1[3]);
                    *(u32x4*)(rowp + bj * 128) = w; } }
    }
};
struct EpiRes {
    static constexpr bool PERM = true;
    const float* x; f16* h; const float* modl;
    DI void operator()(const f32x4 (&acc)[2][2][4][2], const pg8::Unit& u, int wr, int wc, int fr, int fq) const {
        const int row0 = u.pm * 256 + wr * 64 + fr, col0 = u.pn * 256 + wc * 32 + 8 * fq;
        const int b = (u.pm * 256) / T; const float* gp = modl + b * 6144 + 2048 + col0;
        f32x4 gv[2][2];
#pragma unroll
        for (int bj = 0; bj < 2; ++bj)
#pragma unroll
            for (int n = 0; n < 2; ++n) gv[bj][n] = *(const f32x4*)(gp + bj * 128 + 4 * n);
#pragma unroll
        for (int ai = 0; ai < 2; ++ai)
#pragma unroll
            for (int m = 0; m < 4; ++m) { const size_t ro = (size_t)(row0 + ai * 128 + m * 16) * D + col0;
#pragma unroll
                for (int bj = 0; bj < 2; ++bj) { f32x4 r0, r1;
                    if (x) { r0 = *(const f32x4*)(x + ro + bj * 128); r1 = *(const f32x4*)(x + ro + bj * 128 + 4); }
                    else { const u32x4 t = *(const u32x4*)(h + ro + bj * 128); r0 = h4(t.x, t.y); r1 = h4(t.z, t.w); }
                    const f32x4 o0 = r0 + gv[bj][0] * acc[ai][bj][m][0], o1 = r1 + gv[bj][1] * acc[ai][bj][m][1];
                    u32x4 w; w.x = pkh(o0.x, o0.y); w.y = pkh(o0.z, o0.w); w.z = pkh(o1.x, o1.y); w.w = pkh(o1.z, o1.w);
                    *(u32x4*)(h + ro + bj * 128) = w; } }
    }
};
struct EpiSwiglu {
    static constexpr bool PERM = true;
    bf16* H;
    DI void operator()(const f32x4 (&acc)[2][2][4][2], const pg8::Unit& u, int wr, int wc, int fr, int fq) const {
        const int row0 = u.pm * 256 + wr * 64 + fr, col0 = u.pl * 128 + wc * 32 + 8 * fq;
#pragma unroll
        for (int ai = 0; ai < 2; ++ai)
#pragma unroll
            for (int m = 0; m < 4; ++m) { bf16* rowp = H + (size_t)(row0 + ai * 128 + m * 16) * FF + col0;
                float o[8];
#pragma unroll
                for (int n = 0; n < 2; ++n)
#pragma unroll
                    for (int j = 0; j < 4; ++j) o[4 * n + j] = siluf_(acc[ai][0][m][n][j]) * acc[ai][1][m][n][j];
                u32x4 w; w.x = pk2(o[0], o[1]); w.y = pk2(o[2], o[3]); w.z = pk2(o[4], o[5]); w.w = pk2(o[6], o[7]);
                *(u32x4*)rowp = w; }
    }
};
struct EpiDown {
    static constexpr bool PERM = true;
    f16* h; float* outf; const float* modl; const int* list; const float* rtw; const LAS int* cnt; int dense, kpass, fin; float* part;
    DI void operator()(const f32x4 (&acc)[2][2][4][2], const pg8::Unit& u, int wr, int wc, int fr, int fq) const {
        if (u.part >= 0) {
            float* pb = part + (size_t)u.part * 65536 + (wr * 64 + fr) * 256 + wc * 32 + 8 * fq;
#pragma unroll
            for (int ai = 0; ai < 2; ++ai)
#pragma unroll
                for (int m = 0; m < 4; ++m)
#pragma unroll
                    for (int bj = 0; bj < 2; ++bj)
#pragma unroll
                        for (int n = 0; n < 2; ++n) *(f32x4*)(pb + (ai * 128 + m * 16) * 256 + bj * 128 + 4 * n) = acc[ai][bj][m][n];
            return; }
        const int r0 = wr * 64 + fr, col0 = u.pl * 256 + wc * 32 + 8 * fq;
        const int ce = dense ? 0 : cnt[u.e];
#pragma unroll
        for (int ai = 0; ai < 2; ++ai)
#pragma unroll
            for (int m = 0; m < 4; ++m) { const int idx = u.lt * 256 + r0 + ai * 128 + m * 16;
                int tok = idx; float w = 1.f; bool ok = true;
                if (!dense) { ok = idx < ce; tok = ok ? list[u.e * 32768 + idx] : 0; w = ok ? rtw[tok * 2 + kpass] : 0.f; }
                if (ok) { const int b = tok >> 13; const float* gp = modl + b * 6144 + 5120 + col0; f16* hp = h + (size_t)tok * D + col0; float* op = outf + (size_t)tok * D + col0;
#pragma unroll
                    for (int bj = 0; bj < 2; ++bj) { const f32x4 g0 = *(const f32x4*)(gp + bj * 128), g1 = *(const f32x4*)(gp + bj * 128 + 4); const u32x4 t = *(const u32x4*)(hp + bj * 128);
                        const f32x4 o0 = h4(t.x, t.y) + (g0 * w) * acc[ai][bj][m][0], o1 = h4(t.z, t.w) + (g1 * w) * acc[ai][bj][m][1];
                        if (fin) { *(f32x4*)(op + bj * 128) = o0; *(f32x4*)(op + bj * 128 + 4) = o1; }
                        else { u32x4 wv; wv.x = pkh(o0.x, o0.y); wv.y = pkh(o0.z, o0.w); wv.z = pkh(o1.x, o1.y); wv.w = pkh(o1.z, o1.w); *(u32x4*)(hp + bj * 128) = wv; } } } }
    }
};

struct Args { const void* in[34]; float* out; unsigned char* ws; };
typedef const __attribute__((address_space(4))) Args& KArgsR;
enum { I_X = 0, I_C, I_POS, I_ADAW, I_ADAB, I_NMG, I_NFG, I_WIN, I_WOUT, I_CONVW, I_LRE, I_LIM, I_BRE, I_BIM, I_CRE, I_CIM, I_SD, I_LDT, I_WGLU, I_QNG, I_KNG, I_PK, I_PV, I_KW1, I_KW2, I_VW1, I_VW2,
       I_FG, I_FU, I_FD, I_MR, I_MG, I_MU, I_MD };

DI void tr_item(const float* W, int ldw, int K, bf16* WT, int dst_row0, int k0, int n0, LAS float* scr, int lane, int tiled = 0) {
    const int kq = lane >> 4, n4 = (lane & 15) * 4;
    f32x4 v[16];
#pragma unroll
    for (int i = 0; i < 16; ++i) v[i] = *(const f32x4*)(W + (size_t)(k0 + 4 * i + kq) * ldw + n0 + n4);
#pragma unroll
    for (int i = 0; i < 16; ++i) { LAS float* d = scr + (4 * i + kq) * 65 + n4; d[0] = v[i].x; d[1] = v[i].y; d[2] = v[i].z; d[3] = v[i].w; }
    LDS_WAIT(); asm volatile("" ::: "memory");
    const int c = lane & 7;
#pragma unroll
    for (int j = 0; j < 8; ++j) { const int n = (lane >> 3) + 8 * j; const LAS float* s = scr + (8 * c) * 65 + n;
        u32x4 o; o.x = pk2(s[0 * 65], s[1 * 65]); o.y = pk2(s[2 * 65], s[3 * 65]); o.z = pk2(s[4 * 65], s[5 * 65]); o.w = pk2(s[6 * 65], s[7 * 65]);
        const int nabs = dst_row0 + n, kk = k0 + 8 * c;
        bf16* dst = tiled ? WT + ((size_t)((nabs >> 4) * (K >> 5) + (kk >> 5)) * 64 + (nabs & 15) + 16 * ((kk >> 3) & 3)) * 8 : WT + (size_t)nabs * K + kk;
        *(u32x4*)dst = o; }
    LDS_WAIT(); asm volatile("" ::: "memory");
}
DI int gu_row(int n0, int up) { return (n0 >> 7) * 256 + (n0 & 127) + (up ? 128 : 0); }
constexpr int IT_WIN = 16 * 44, IT_WOUT = 16 * 16, IT_GU = 16 * 56, IT_DN = 56 * 16, IT_C1 = 32 * 4, IT_C2 = 4 * 1, IT_GLU = 4 * 4;
constexpr int IT_TOTAL = 2 * (IT_WIN + IT_WOUT) + (2 * IT_GU + IT_DN) * 9 + 4 * IT_C1 + 4 * IT_C2 + 2 * IT_GLU;
DI void conv_item(KArgsR a, int r, LAS float* scr, int lane) {
    unsigned char* ws = a.ws;
    const float* W; int ldw, K, row0, kb, nb, tiled = 0; bf16* WT;
    const int per_l = IT_WIN + IT_WOUT;
    if (r < 2 * per_l) { const int l = r / per_l; r -= l * per_l;
        if (r < IT_WIN) { kb = r / 44; nb = r % 44; W = (const float*)a.in[I_WIN] + (size_t)l * D * NIN; ldw = NIN; K = D; WT = (bf16*)(ws + WS_WIN) + (size_t)l * NZ * D; row0 = 64 * nb; }
        else { r -= IT_WIN; kb = r / 16; nb = r % 16; W = (const float*)a.in[I_WOUT] + (size_t)l * D * D; ldw = D; K = D; WT = (bf16*)(ws + WS_WOUT) + (size_t)l * D * D; row0 = 64 * nb; } }
    else { r -= 2 * per_l;
        constexpr int PER_E = 2 * IT_GU + IT_DN;
        if (r < 9 * PER_E) {
            const int e = r / PER_E; r -= e * PER_E; const int ex = e > 0 ? e - 1 : 0;
            if (r < 2 * IT_GU) { const int up = r >= IT_GU; r -= up * IT_GU; kb = r / 56; nb = r % 56; ldw = FF; K = D; row0 = gu_row(64 * nb, up);
                W = e == 0 ? (const float*)a.in[up ? I_FU : I_FG] : (const float*)a.in[up ? I_MU : I_MG] + (size_t)ex * D * FF;
                WT = e == 0 ? (bf16*)(ws + WS_WGUD) : (bf16*)(ws + WS_WGUM) + (size_t)ex * 7168 * D; }
            else { r -= 2 * IT_GU; kb = r / 16; nb = r % 16; ldw = D; K = FF; row0 = 64 * nb;
                W = e == 0 ? (const float*)a.in[I_FD] : (const float*)a.in[I_MD] + (size_t)ex * FF * D;
                WT = e == 0 ? (bf16*)(ws + WS_WDD) : (bf16*)(ws + WS_WDM) + (size_t)ex * D * FF; } }
        else { r -= 9 * PER_E;
            if (r < 4 * IT_C1) { const int m = r / IT_C1, rr = r % IT_C1, l = m >> 1, kv = m & 1; kb = rr / 4; nb = rr % 4; ldw = 256; K = 2048; row0 = 64 * nb; tiled = 1;
                W = (const float*)a.in[kv ? I_VW1 : I_KW1] + (size_t)l * 2048 * 256; WT = (bf16*)(ws + WS_CW1) + (size_t)m * 256 * 2048; }
            else { r -= 4 * IT_C1;
                if (r < 4 * IT_C2) { const int m = r / IT_C2, rr = r % IT_C2, l = m >> 1, kv = m & 1; kb = rr; nb = 0; ldw = 64; K = 256; row0 = 0;
                    W = (const float*)a.in[kv ? I_VW2 : I_KW2] + (size_t)l * 256 * 64; WT = (bf16*)(ws + WS_CW2) + (size_t)m * 64 * 256; }
                else { r -= 4 * IT_C2; const int l = r / IT_GLU, rr = r % IT_GLU; kb = rr / 4; nb = rr % 4; ldw = 256; K = 256; row0 = 64 * nb;
                    W = (const float*)a.in[I_WGLU] + (size_t)l * 256 * 256; WT = (bf16*)(ws + WS_WGLU) + (size_t)l * 256 * 256; } } } }
    tr_item(W, ldw, K, WT, row0, 64 * kb, 64 * nb, scr, lane, tiled);
}

DI void prologue(KArgsR a, LAS unsigned char* lds, int tid, int lane, int wave, int G) {
    LAS float* condL = (LAS float*)(lds + 98304);
    for (int i = tid; i < 4096; i += 512) condL[i] = siluf_(((const float*)a.in[I_C])[i]);
    __syncthreads();
    const int gw = blockIdx.x * 8 + wave, NGW = G * 8;
    for (int mt = gw; mt < 192; mt += NGW) {
        const int l = mt / 96, n = (mt % 96) * 64 + lane;
        const float* wp = (const float*)a.in[I_ADAW] + (size_t)l * D * 6144 + n;
        float acc[4] = {0.f, 0.f, 0.f, 0.f};
        for (int k0 = 0; k0 < D; k0 += 16) {
            float w[16];
#pragma unroll
            for (int i = 0; i < 16; ++i) w[i] = wp[(size_t)(k0 + i) * 6144];
#pragma unroll
            for (int i = 0; i < 16; ++i)
#pragma unroll
                for (int b = 0; b < 4; ++b) acc[b] += condL[b * 1024 + k0 + i] * w[i];
        }
        const float bias = ((const float*)a.in[I_ADAB])[l * 6144 + n];
#pragma unroll
        for (int b = 0; b < 4; ++b) ((float*)(a.ws + WS_MOD))[(l * 4 + b) * 6144 + n] = acc[b] + bias;
    }
    for (int ct = gw - 192; ct >= 0 && ct < 16; ct += NGW) {
        const int l = ct >> 3, kv = (ct >> 2) & 1, n = (ct & 3) * 64 + lane;
        const float* pos = (const float*)a.in[kv ? I_PV : I_PK] + l * 2048; const float* w1 = (const float*)a.in[kv ? I_VW1 : I_KW1] + (size_t)l * 2048 * 256 + n;
        float acc = 0.f;
        for (int k0 = 0; k0 < 2048; k0 += 16) {
            float w[16];
#pragma unroll
            for (int i = 0; i < 16; ++i) w[i] = w1[(size_t)(k0 + i) * 256];
#pragma unroll
            for (int i = 0; i < 16; ++i) acc += pos[k0 + i] * w[i];
        }
        ((float*)(a.ws + WS_CBIAS))[(l * 2 + kv) * 256 + n] = acc;
    }
    __syncthreads();
    LAS float* scr = (LAS float*)(lds + wave * 16640);
    for (int it = gw; it < IT_TOTAL; it += NGW) conv_item(a, it, scr, lane);
}

template <bool F16> struct NormRaw { typedef u32x4 T; }; template <> struct NormRaw<true> { typedef u32x2 T; };
template <int NS, bool F16, int RPW = 16>
DI void norm_phase(KArgsR a, const void* hin, const float* gain, const float* modl, int sh_off, const float* Wsm, int ldws, LAS unsigned char* lds, int tid, int lane, int wave, int G, int rowbeg = 0, int nrows = M, size_t aoff = OB_A) {
    static_assert(NS != 8 || RPW == 16, "the routing path keeps one row per lane 0..15");
    LAS float* Ws = (LAS float*)lds;
    LAS int* lc = (LAS int*)(lds + LDSCTL_OFF);
    gu32* ctl = (gu32*)(a.ws + WS_CTL);
    bf16* aout = (bf16*)((unsigned char*)a.out + aoff);
    if constexpr (NS > 0) {
        for (int i = tid; i < NS * 1024; i += 512) { const int k = i / NS, n = i % NS; Ws[n * 1024 + k] = Wsm[(size_t)k * ldws + n]; }
        __syncthreads();
    }
    for (int base = blockIdx.x * 8; base < nrows / RPW; base += G * 8) {
        const int rb = base + wave, row0 = rowbeg + rb * RPW, b = row0 / T;
        f32x4 Av[4], Bv[4];
#pragma unroll
        for (int j = 0; j < 4; ++j) { const int col = 4 * lane + 256 * j;
            const f32x4 g4 = *(const f32x4*)(gain + col), sc = *(const f32x4*)(modl + b * 6144 + sh_off + 1024 + col);
            Av[j] = g4 * (sc + 1.0f); Bv[j] = *(const f32x4*)(modl + b * 6144 + sh_off + col); }
        int e0k = 0, e1k = 0, p0k = 0, p1k = 0;
        if constexpr (NS == 8) { if (tid < 16) lc[LC_LCNT + tid] = 0; __syncthreads(); }
        typedef typename NormRaw<F16>::T RawT;
        constexpr int PF = NORM_PF; static_assert(RPW % PF == 0, "ring depth");
        RawT vn[PF][4];
#pragma unroll
        for (int k = 0; k < PF; ++k) { const RawT* xr0 = (const RawT*)hin + (size_t)(row0 + k) * (D / 4) + lane;
#pragma unroll
            for (int j = 0; j < 4; ++j) vn[k][j] = xr0[64 * j]; }
#pragma unroll 1
        for (int rr0 = 0; rr0 < RPW; rr0 += PF) {
#pragma unroll
          for (int k = 0; k < PF; ++k) {
            const int rr = rr0 + k, row = row0 + rr;
            f32x4 v[4]; float ss = 0.f;
#pragma unroll
            for (int j = 0; j < 4; ++j) { if constexpr (F16) v[j] = h4(vn[k][j].x, vn[k][j].y); else v[j] = __builtin_bit_cast(f32x4, vn[k][j]);
                ss += (v[j].x * v[j].x + v[j].y * v[j].y) + (v[j].z * v[j].z + v[j].w * v[j].w); }
            if (rr + PF < RPW) { const RawT* xn = (const RawT*)hin + (size_t)(row + PF) * (D / 4) + lane;
#pragma unroll
                for (int j = 0; j < 4; ++j) vn[k][j] = xn[64 * j]; }
            const float rstd = rsqrtf(wave_sum(ss) * (1.f / D) + RMS_EPS);
            unsigned long long* o8 = (unsigned long long*)(aout + (size_t)row * D) + lane;
#pragma unroll
            for (int j = 0; j < 4; ++j) { v[j] = (v[j] * rstd) * Av[j] + Bv[j];
                o8[64 * j] = (unsigned long long)pk2(v[j].x, v[j].y) | ((unsigned long long)pk2(v[j].z, v[j].w) << 32); }
            if constexpr (NS > 0) {
                constexpr int NV = (NS > 8) ? 16 : 8;
                float pa[NV];
#pragma unroll
                for (int n = 0; n < NV; ++n) { float acc = 0.f;
                    if (n < NS) {
#pragma unroll
                        for (int j = 0; j < 4; ++j) { const f32x4 w = *(const LAS f32x4*)(Ws + n * 1024 + 4 * lane + 256 * j); acc += (v[j].x * w.x + v[j].y * w.y) + (v[j].z * w.z + v[j].w * w.w); } }
                    pa[n] = acc; if ((n & 3) == 3) __builtin_amdgcn_sched_barrier(0); }
#define NP_BFLY(cnt, off) { const bool up = (lane & (off)) != 0; _Pragma("unroll") for (int i = 0; i < (cnt); ++i) { const float keep = up ? pa[i + (cnt)] : pa[i], send = up ? pa[i] : pa[i + (cnt)]; pa[i] = keep + __shfl_xor(send, (off)); } }
                float tot;
                if constexpr (NV == 16) { NP_BFLY(8, 32) NP_BFLY(4, 16) NP_BFLY(2, 8) NP_BFLY(1, 4) tot = pa[0]; tot += __shfl_xor(tot, 2); tot += __shfl_xor(tot, 1); }
                else { NP_BFLY(4, 32) NP_BFLY(2, 16) NP_BFLY(1, 8) tot = pa[0]; tot += __shfl_xor(tot, 4); tot += __shfl_xor(tot, 2); tot += __shfl_xor(tot, 1); }
#undef NP_BFLY
                const float o = __shfl(tot, (lane * (64 / NV)) & 63);
                if constexpr (NS == 12) {
                    if (lane < 12) ((float*)(a.ws + WS_GL))[(size_t)row * 12 + lane] = o;
                } else {
                    const float c0 = (lane < 8) ? o : -3.0e38f; const float v0 = wave_max(c0);
                    const int i0 = __builtin_ctzll(__ballot(c0 == v0));
                    const float c1v = (lane < 8 && lane != i0) ? o : -3.0e38f; const float v1 = wave_max(c1v);
                    const int i1 = __builtin_ctzll(__ballot(c1v == v1 && lane < 8 && lane != i0));
                    const float w0 = __builtin_amdgcn_rcpf(1.f + fexp(v1 - v0));
                    if (lane == 0) { ((float*)(a.ws + WS_RTW))[row * 2] = w0; ((float*)(a.ws + WS_RTW))[row * 2 + 1] = 1.f - w0; }
                    if (lane == rr) { const int lp0 = __hip_atomic_fetch_add(&lc[LC_LCNT + i0], 1, __ATOMIC_RELAXED, __HIP_MEMORY_SCOPE_WORKGROUP); const int lp1 = __hip_atomic_fetch_add(&lc[LC_LCNT + 8 + i1], 1, __ATOMIC_RELAXED, __HIP_MEMORY_SCOPE_WORKGROUP);
                        e0k = i0; e1k = i1; p0k = lp0; p1k = lp1; }
                }
            }
          }
        }
        if constexpr (NS == 8) {
            __syncthreads();
            if (tid < 16) lc[LC_BASE + tid] = (int)__hip_atomic_fetch_add(ctl + CW_CNT + tid * 64, (unsigned)lc[LC_LCNT + tid], RLX_AGENT);
            __syncthreads();
            if (lane < 16) { int* list = (int*)(a.ws + WS_LIST);
                list[(0 * 8 + e0k) * 32768 + lc[LC_BASE + e0k] + p0k] = row0 + lane;
                list[(1 * 8 + e1k) * 32768 + lc[LC_BASE + 8 + e1k] + p1k] = row0 + lane; }
            __syncthreads();
        }
    }
}

DI u32x4 ldg16(const bf16* p) { return *(const u32x4*)p; }

DI void conv_tile(KArgsR a, int l, int b, int t0, int tid) {
    const bf16* z = (const bf16*)(a.ws + WS_Z); bf16* y = (bf16*)(a.ws + WS_Y);
    const float* cw = (const float*)a.in[I_CONVW] + l * 3 * 256;
    for (int it = tid; it < 64 * 32; it += 512) {
        const int tl = it >> 5, c8 = (it & 31) * 8, t = t0 + tl; const size_t row = (size_t)b * T + t;
        float acc[8];
#pragma unroll
        for (int i = 0; i < 8; ++i) acc[i] = 0.f;
#pragma unroll
        for (int jj = 0; jj < 3; ++jj) { const int tt = t - 2 + jj;
            if (tt >= 0) { const size_t r2 = (size_t)b * T + tt; const u32x4 gc = ldg16(z + r2 * NZ + ZC_CC + c8), uu = ldg16(z + r2 * NZ + ZC_CU + c8);
                const f32x4 w0 = *(const f32x4*)(cw + jj * 256 + c8), w1 = *(const f32x4*)(cw + jj * 256 + c8 + 4);
                acc[0] += w0.x * (bflo(gc.x) * bflo(uu.x)); acc[1] += w0.y * (bfhi(gc.x) * bfhi(uu.x)); acc[2] += w0.z * (bflo(gc.y) * bflo(uu.y)); acc[3] += w0.w * (bfhi(gc.y) * bfhi(uu.y));
                acc[4] += w1.x * (bflo(gc.z) * bflo(uu.z)); acc[5] += w1.y * (bfhi(gc.z) * bfhi(uu.z)); acc[6] += w1.z * (bflo(gc.w) * bflo(uu.w)); acc[7] += w1.w * (bfhi(gc.w) * bfhi(uu.w)); } }
        const u32x4 gb = ldg16(z + row * NZ + ZC_CB + c8);
        u32x4 o; o.x = pk2(bflo(gb.x) * acc[0], bfhi(gb.x) * acc[1]); o.y = pk2(bflo(gb.y) * acc[2], bfhi(gb.y) * acc[3]); o.z = pk2(bflo(gb.z) * acc[4], bfhi(gb.z) * acc[5]); o.w = pk2(bflo(gb.w) * acc[6], bfhi(gb.w) * acc[7]);
        *(u32x4*)(y + row * D + c8) = o;
    }
}
DI float norm_rope(float x, float gain, float cs, float sn, int lane) {
    const float ss = wave_sum(x * x); const float r = rsqrtf(ss * (1.f / 64.f) + RMS_EPS);
    const float xn = x * r * gain; const float pr = __shfl_xor(xn, 32);
    return (lane < 32) ? (xn * cs - pr * sn) : (xn * cs + pr * sn);
}
DI void rope_cs(int pos, int lane, float& cs, float& sn) {
    const int i = lane & 31; const float inv = exp2f(-(float)i * (13.287712379549449f / 32.f));
    const float ang = (float)pos * inv; sincosf(ang, &sn, &cs);
}
DI void prep_tile(KArgsR a, int l, int b, int t0, LAS unsigned char* lds, int tid, int lane, int wave) {
    bf16* z = (bf16*)(a.ws + WS_Z);
    const float qg = ((const float*)a.in[I_QNG])[l * 64 + lane], kg = ((const float*)a.in[I_KNG])[l * 64 + lane];
    const int* posp = (const int*)a.in[I_POS];
    unsigned nraw[8], nrawk[4]; int npos;
#define PT_LOAD(i_) do { const size_t row_ = (size_t)b * T + t0 + wave * 8 + (i_); \
        _Pragma("unroll") for (int hh = 0; hh < 8; ++hh) { const int col = (hh < 4) ? ZC_NQ + hh * 64 : (hh < 6 ? ZC_KV + 2 * 128 + (hh - 4) * 64 : ZC_KV + 4 * 128 + (hh - 6) * 64); nraw[hh] = z[row_ * NZ + col + lane]; } \
        _Pragma("unroll") for (int hd = 0; hd < 4; ++hd) nrawk[hd] = z[row_ * NZ + ZC_SBK + hd * 64 + lane]; \
        npos = posp[row_]; } while (0)
    PT_LOAD(0);
#pragma unroll 1
    for (int i = 0; i < 8; ++i) {
        const int t = t0 + wave * 8 + i; const size_t row = (size_t)b * T + t;
        unsigned raw[8], rawk[4];
#pragma unroll
        for (int hh = 0; hh < 8; ++hh) raw[hh] = nraw[hh];
#pragma unroll
        for (int hd = 0; hd < 4; ++hd) rawk[hd] = nrawk[hd];
        const int pos = npos;
        if (i < 7) PT_LOAD(i + 1);
        float cs, sn; rope_cs(pos, lane, cs, sn);
#pragma unroll
        for (int hd = 0; hd < 4; ++hd) { bf16* kf = (bf16*)((unsigned char*)a.out + OB_KFSB) + (size_t)(b * 4 + hd) * T * 64;
            kf[((size_t)((t >> 5) * 4 + (lane >> 4)) * 64 + (t & 31) + 32 * ((lane >> 3) & 1)) * 8 + (lane & 7)] = (bf16)rawk[hd]; }
#pragma unroll
        for (int hh = 0; hh < 8; ++hh) {
            const int col = (hh < 4) ? ZC_NQ + hh * 64 : (hh < 6 ? ZC_KV + 2 * 128 + (hh - 4) * 64 : ZC_KV + 4 * 128 + (hh - 6) * 64);
            const float o = norm_rope(bf2f(raw[hh]), hh < 4 ? qg : kg, cs, sn, lane);
            z[row * NZ + col + lane] = (bf16)f2bf(o);
            if (hh >= 4) {
                bf16* kf = (bf16*)((unsigned char*)a.out + (hh < 6 ? OB_KFSLC : OB_KFWIN)) + (size_t)(b * 2 + (hh & 1)) * T * 64;
                kf[((size_t)((t >> 5) * 4 + (lane >> 4)) * 64 + (t & 31) + 32 * ((lane >> 3) & 1)) * 8 + (lane & 7)] = (bf16)f2bf(o); }
        }
    }
#undef PT_LOAD
    LAS unsigned* scr = (LAS unsigned*)(lds + 32768 + wave * 1280);
    u32x4 vv[8];
#pragma unroll
    for (int k = 0; k < 8; ++k) { const int c0 = 8 * (wave + 8 * k); int zc0;
        if (c0 < 256) zc0 = ZC_SBV + c0; else if (c0 < 384) zc0 = ZC_KV + 3 * 128 + (c0 - 256); else zc0 = ZC_KV + 5 * 128 + (c0 - 384);
        vv[k] = *(const u32x4*)(z + ((size_t)b * T + t0 + lane) * NZ + zc0); }
#pragma unroll
    for (int k = 0; k < 8; ++k) {
        const int cb = wave + 8 * k, c0 = 8 * cb; const u32x4 v = vv[k];
        scr[lane * 5 + 0] = v.x; scr[lane * 5 + 1] = v.y; scr[lane * 5 + 2] = v.z; scr[lane * 5 + 3] = v.w;
        LDS_WAIT();
        const int ch = lane >> 3, o = lane & 7; const LAS bf16* sp = (const LAS bf16*)scr + ch;
        unsigned e[8];
#pragma unroll
        for (int j = 0; j < 8; ++j) e[j] = sp[(8 * o + j) * 10];
        const int c = c0 + ch, d = c & 63, key = t0 + 8 * o, kt = key >> 5, kk = key & 31, sp2 = kk >> 4, jh = (kk >> 3) & 1;
        bf16* base = (c < 256) ? (bf16*)((unsigned char*)a.out + OB_VFSB) + (size_t)(b * 4 + (c >> 6)) * T * 64 : (c < 384) ? (bf16*)((unsigned char*)a.out + OB_VFSLC) + (size_t)(b * 2 + ((c - 256) >> 6)) * T * 64 : (bf16*)((unsigned char*)a.out + OB_VFWIN) + (size_t)(b * 2 + ((c - 384) >> 6)) * T * 64;
        bf16* vf = base + ((size_t)((kt * 2 + (d >> 5)) * 2 + sp2) * 64 + (d & 31)) * 8 + 4 * jh;
        *(u32x2*)vf = (u32x2){e[0] | (e[1] << 16), e[2] | (e[3] << 16)};
        *(u32x2*)(vf + 32 * 8) = (u32x2){e[4] | (e[5] << 16), e[6] | (e[7] << 16)};
        LDS_WAIT();
    }
}

struct S5P { float lbr, lbi; float br[16], bi[16]; };
DI void s5_params(KArgsR a, int l, int g, int p, S5P& P) {
    const int gi = (l * 16 + g) * 64 + p;
    const float lre = fminf(((const float*)a.in[I_LRE])[gi], -1e-4f), lim = ((const float*)a.in[I_LIM])[gi];
    const float dt = expf(((const float*)a.in[I_LDT])[l * 16 + g]);
    const float mag = expf(lre * dt); float s, c; sincosf(lim * dt, &s, &c);
    P.lbr = mag * c; P.lbi = mag * s;
    const float nr = P.lbr - 1.f, ni = P.lbi, den = 1.f / (lre * lre + lim * lim);
    const float cr = (nr * lre + ni * lim) * den, ci = (ni * lre - nr * lim) * den;
    const float* bre = (const float*)a.in[I_BRE] + (size_t)gi * 16; const float* bim = (const float*)a.in[I_BIM] + (size_t)gi * 16;
#pragma unroll
    for (int q = 0; q < 4; ++q) { const f32x4 r4 = *(const f32x4*)(bre + 4 * q), i4 = *(const f32x4*)(bim + 4 * q);
#pragma unroll
        for (int j = 0; j < 4; ++j) { P.br[4 * q + j] = cr * r4[j] - ci * i4[j]; P.bi[4 * q + j] = cr * i4[j] + ci * r4[j]; } }
}
DI void s5_load_ublock(const bf16* z, int b, int tc0, LAS unsigned char* ub, int tid) {
#pragma unroll
    for (int k = 0; k < 4; ++k) { const int it = tid + 512 * k, r = it >> 5, c16 = it & 31;
        *(LAS u32x4*)(ub + r * 528 + c16 * 16) = *(const u32x4*)(z + ((size_t)b * T + tc0 + r) * NZ + ZC_SSM + c16 * 8); }
    __syncthreads();
}
DI void s5_stage_u(const LAS unsigned char* ub, int g, LAS float* us, int lane) {
    const LAS u32x4* p = (const LAS u32x4*)(ub + lane * 528 + g * 32);
    const u32x4 v0 = p[0], v1 = p[1];
    LAS f32x4* d = (LAS f32x4*)(us + lane * 16);
    d[0] = (f32x4){bflo(v0.x), bfhi(v0.x), bflo(v0.y), bfhi(v0.y)}; d[1] = (f32x4){bflo(v0.z), bfhi(v0.z), bflo(v0.w), bfhi(v0.w)};
    d[2] = (f32x4){bflo(v1.x), bfhi(v1.x), bflo(v1.y), bfhi(v1.y)}; d[3] = (f32x4){bflo(v1.z), bfhi(v1.z), bflo(v1.w), bfhi(v1.w)};
    LDS_WAIT();
}
DI void s5_bu(const S5P& P, const LAS float* ut, float& bur, float& bui) {
    const f32x4 u0 = *(const LAS f32x4*)(ut), u1 = *(const LAS f32x4*)(ut + 4), u2 = *(const LAS f32x4*)(ut + 8), u3 = *(const LAS f32x4*)(ut + 12);
    float ar = 0.f, ai = 0.f, cr = 0.f, ci = 0.f;
#pragma unroll
    for (int j = 0; j < 4; ++j) { ar += P.br[j] * u0[j]; ai += P.bi[j] * u0[j]; cr += P.br[4 + j] * u1[j]; ci += P.bi[4 + j] * u1[j]; }
#pragma unroll
    for (int j = 0; j < 4; ++j) { ar += P.br[8 + j] * u2[j]; ai += P.bi[8 + j] * u2[j]; cr += P.br[12 + j] * u3[j]; ci += P.bi[12 + j] * u3[j]; }
    bur = ar + cr; bui = ai + ci;
}
DI void s5_rec(const S5P& P, float bur, float bui, float& hr, float& hi) { const float nr = P.lbr * hr - P.lbi * hi + bur, ni = P.lbr * hi + P.lbi * hr + bui; hr = nr; hi = ni; }
DI void s5_pass1(KArgsR a, int l, int b, int ch, LAS unsigned char* lds, int tid, int lane, int wave) {
    const bf16* z = (const bf16*)(a.ws + WS_Z); LAS float* us = (LAS float*)(lds + wave * 4096); LAS unsigned char* ub = lds + 49152;
    __syncthreads();
    s5_load_ublock(z, b, ch * 64, ub, tid);
    for (int gg = 0; gg < 2; ++gg) {
        const int g = wave * 2 + gg; S5P P; s5_params(a, l, g, lane, P);
        s5_stage_u(ub, g, us, lane);
        float hr = 0.f, hi = 0.f;
#pragma unroll 1
        for (int t = 0; t < 64; t += 4) { float br4[4], bi4[4];
#pragma unroll
            for (int k = 0; k < 4; ++k) s5_bu(P, us + (t + k) * 16, br4[k], bi4[k]);
#pragma unroll
            for (int k = 0; k < 4; ++k) s5_rec(P, br4[k], bi4[k], hr, hi); }
        ((f32x2*)(a.ws + WS_S5E))[((size_t)(b * 16 + g) * 128 + ch) * 64 + lane] = (f32x2){hr, hi};
        LDS_WAIT();
    }
}

DI void cmp_task(KArgsR a, int l, int task, LAS unsigned char* lds, int tid, int lane, int wave) {
    const int itile = task & 15, g = (task >> 4) & 1, b = (task >> 5) & 3, kv = task >> 7;
    const bf16* z = (const bf16*)(a.ws + WS_Z);
    const bf16* w1t = (const bf16*)(a.ws + WS_CW1) + (size_t)(l * 2 + kv) * 256 * 2048;
    const bf16* w2t = (const bf16*)(a.ws + WS_CW2) + (size_t)(l * 2 + kv) * 64 * 256;
    const float* cb = (const float*)(a.ws + WS_CBIAS) + (l * 2 + kv) * 256;
    LAS bf16* Hs = (LAS bf16*)lds;
    LAS float* Os = (LAS float*)(lds + 32 * 264 * 2);
    const int fr = lane & 15, fq = lane >> 4, i0 = itile * 32;
    const int zc = ZC_KV + kv * 128 + g * 64;
    f32x4 acc[2][2];
#pragma unroll
    for (int rb = 0; rb < 2; ++rb)
#pragma unroll
        for (int cbk = 0; cbk < 2; ++cbk) acc[rb][cbk] = (f32x4){0.f, 0.f, 0.f, 0.f};
    const bf16* arow[2];
#pragma unroll
    for (int rb = 0; rb < 2; ++rb) arow[rb] = z + ((size_t)b * T + 16 * (i0 + 16 * rb + fr)) * NZ + zc + 8 * fq;
    const bf16* brow[2];
#pragma unroll
    for (int cbk = 0; cbk < 2; ++cbk) brow[cbk] = w1t + ((size_t)(2 * wave + cbk) * 64 * 64 + lane) * 8;
#define CMP_LOAD(AF, BF, kb_) do { _Pragma("unroll") for (int u_ = 0; u_ < 4; ++u_) { const int ks_ = 4 * (kb_) + u_; const int j_ = ks_ >> 1, d0_ = (ks_ & 1) * 32; \
        _Pragma("unroll") for (int rb = 0; rb < 2; ++rb) AF[u_][rb] = *(const bf16x8*)(arow[rb] + (size_t)j_ * NZ + d0_); \
        _Pragma("unroll") for (int cbk = 0; cbk < 2; ++cbk) BF[u_][cbk] = *(const bf16x8*)(brow[cbk] + 512 * ks_); } } while (0)
#define CMP_MMA(AF, BF) do { _Pragma("unroll") for (int u_ = 0; u_ < 4; ++u_) _Pragma("unroll") for (int rb = 0; rb < 2; ++rb) _Pragma("unroll") for (int cbk = 0; cbk < 2; ++cbk) \
        acc[rb][cbk] = __builtin_amdgcn_mfma_f32_16x16x32_bf16(AF[u_][rb], BF[u_][cbk], acc[rb][cbk], 0, 0, 0); } while (0)
#ifdef DBL_G1
    for (int rep_ = 0; rep_ < 2; ++rep_) { asm volatile("" : "+v"(arow[0]), "+v"(brow[0])); if (rep_ == 1) { acc[0][0] = acc[0][1] = acc[1][0] = acc[1][1] = (f32x4){0.f, 0.f, 0.f, 0.f}; }
#else
    {
#endif
    { bf16x8 a0[4][2], b0[4][2], a1[4][2], b1[4][2];
      CMP_LOAD(a0, b0, 0);
#pragma unroll 1
      for (int kb = 0; kb < 16; kb += 2) {
          CMP_LOAD(a1, b1, kb + 1);
          CMP_MMA(a0, b0);
          if (kb + 2 < 16) CMP_LOAD(a0, b0, kb + 2);
          CMP_MMA(a1, b1);
      } }
    }
#undef CMP_LOAD
#undef CMP_MMA
#pragma unroll
    for (int rb = 0; rb < 2; ++rb)
#pragma unroll
        for (int cbk = 0; cbk < 2; ++cbk) { const int n = 32 * wave + 16 * cbk + fr; const float bias = cb[n];
#pragma unroll
            for (int jj = 0; jj < 4; ++jj) Hs[(16 * rb + 4 * fq + jj) * 264 + n] = (bf16)f2bf(siluf_(acc[rb][cbk][jj] + bias)); }
    __syncthreads();
    { const int rb = wave >> 2, cbk = wave & 3; f32x4 o = (f32x4){0.f, 0.f, 0.f, 0.f};
#pragma unroll
        for (int ks = 0; ks < 8; ++ks) { const bf16x8 af = *(const LAS bf16x8*)(Hs + (16 * rb + fr) * 264 + 32 * ks + 8 * fq);
            const bf16x8 bfr = *(const bf16x8*)(w2t + (size_t)(16 * cbk + fr) * 256 + 32 * ks + 8 * fq);
            o = __builtin_amdgcn_mfma_f32_16x16x32_bf16(af, bfr, o, 0, 0, 0); }
#pragma unroll
        for (int jj = 0; jj < 4; ++jj) Os[(16 * rb + 4 * fq + jj) * 65 + 16 * cbk + fr] = o[jj]; }
    __syncthreads();
    if (kv == 0) {
        const float kg = ((const float*)a.in[I_KNG])[l * 64 + lane];
        bf16* kf = (bf16*)(a.ws + WS_KC) + (size_t)(b * 2 + g) * 512 * 64;
        for (int r = 0; r < 4; ++r) { const int il = wave * 4 + r, i = i0 + il; float o = 0.f;
            if (i < NC) { float cs, sn; rope_cs(((const int*)a.in[I_POS])[b * T + 16 * i + 31], lane, cs, sn); o = norm_rope(Os[il * 65 + lane], kg, cs, sn, lane); }
            kf[((size_t)((i >> 5) * 4 + (lane >> 4)) * 64 + (i & 31) + 32 * ((lane >> 3) & 1)) * 8 + (lane & 7)] = (bf16)f2bf(o); }
    } else {
        const int d = tid >> 3, i4 = (tid & 7) * 4;
        float v[4];
#pragma unroll
        for (int jj = 0; jj < 4; ++jj) v[jj] = (i0 + i4 + jj < NC) ? Os[(i4 + jj) * 65 + d] : 0.f;
        u32x2 w; w.x = pk2(v[0], v[1]); w.y = pk2(v[2], v[3]);
        const int key = i0 + i4, kt = key >> 5, kk = key & 31, sp = kk >> 4, jh = (kk >> 3) & 1, hh = (kk >> 2) & 1;
        bf16* vf = (bf16*)(a.ws + WS_VCT) + (size_t)(b * 2 + g) * 512 * 64 + ((size_t)((kt * 2 + (d >> 5)) * 2 + sp) * 64 + (d & 31) + 32 * hh) * 8 + 4 * jh;
        *(u32x2*)vf = w;
    }
    __syncthreads();
}

DI void s5_carry(KArgsR a, int l, int bg, int lane, gu32* flag) {
    const int b = bg >> 4, g = bg & 15; S5P P; s5_params(a, l, g, lane, P);
    float lr = P.lbr, li = P.lbi;
#pragma unroll
    for (int i = 0; i < 6; ++i) { const float nr = lr * lr - li * li, t2 = lr * li, ni = t2 + t2; lr = nr; li = ni; }
    const f32x2* E = (const f32x2*)(a.ws + WS_S5E) + (size_t)(b * 16 + g) * 128 * 64 + lane;
    typedef GAS unsigned long long gu64;
    gu64* C = (gu64*)(a.ws + WS_S5C) + (size_t)(b * 16 + g) * 128 * 64 + lane;
    float hr = 0.f, hi = 0.f;
#pragma unroll 1
    for (int k0 = 0; k0 < 128; k0 += 8) {
        f32x2 e[8];
#pragma unroll
        for (int i = 0; i < 8; ++i) e[i] = E[(size_t)(k0 + i) * 64];
#pragma unroll
        for (int i = 0; i < 8; ++i) {
            const unsigned long long bits = (unsigned long long)__builtin_bit_cast(unsigned, hr) | ((unsigned long long)__builtin_bit_cast(unsigned, hi) << 32);
            __hip_atomic_store(C + (size_t)(k0 + i) * 64, bits, RLX_AGENT);
            const float nr = lr * hr - li * hi + e[i].x, ni = lr * hi + li * hr + e[i].y; hr = nr; hi = ni; }
    }
    asm volatile("s_waitcnt vmcnt(0)" ::: "memory");
    if (lane == 0) __hip_atomic_fetch_add(flag, 1u, RLX_AGENT);
}
DI void s5_carry_wait(gu32* flag, int tid) {
    if (tid == 0) { unsigned sp = 0; while (__hip_atomic_load(flag, RLX_AGENT) < 64u) { __builtin_amdgcn_s_sleep(2); if (++sp > (1u << 22)) break; }
        __builtin_amdgcn_fence(__ATOMIC_ACQUIRE, "agent"); asm volatile("s_waitcnt vmcnt(0)" ::: "memory"); }
    __syncthreads();
}
DI void s5_pass2(KArgsR a, int l, int b, int ch, LAS unsigned char* lds, int tid, int lane, int wave) {
    const bf16* z = (const bf16*)(a.ws + WS_Z); bf16* y = (bf16*)(a.ws + WS_Y);
    LAS bf16* Gt = (LAS bf16*)lds;
    LAS float* us = (LAS float*)(lds + 34816 + wave * 8704);
    LAS unsigned* Hs = (LAS unsigned*)(lds + 34816 + wave * 8704 + 4096);
    const int fr = lane & 15, fq = lane >> 4, tc0 = ch * 64; LAS unsigned char* ub = lds + 104448;
    s5_load_ublock(z, b, tc0, ub, tid);
    for (int gg = 0; gg < 2; ++gg) {
        const int g = wave * 2 + gg; S5P P; s5_params(a, l, g, lane, P);
        const f32x2 c0 = ((const f32x2*)(a.ws + WS_S5C))[((size_t)(b * 16 + g) * 128 + ch) * 64 + lane];
        float hr = c0.x, hi = c0.y;
        bf16x8 Bf[4];
        { const float* cre = (const float*)a.in[I_CRE] + ((size_t)(l * 16 + g) * 16 + fr) * 64; const float* cim = (const float*)a.in[I_CIM] + ((size_t)(l * 16 + g) * 16 + fr) * 64;
#pragma unroll
            for (int ks = 0; ks < 4; ++ks) { const f32x4 r4 = *(const f32x4*)(cre + 16 * ks + 4 * fq), i4 = *(const f32x4*)(cim + 16 * ks + 4 * fq);
                u32x4 w; w.x = pk2(r4.x, -i4.x); w.y = pk2(r4.y, -i4.y); w.z = pk2(r4.z, -i4.z); w.w = pk2(r4.w, -i4.w); Bf[ks] = __builtin_bit_cast(bf16x8, w); } }
        const float dsk = ((const float*)a.in[I_SD])[l * 256 + g * 16 + fr];
        s5_stage_u(ub, g, us, lane);
        for (int tb = 0; tb < 64; tb += 16) {
#pragma unroll 1
            for (int t = 0; t < 16; t += 4) { float br4[4], bi4[4];
#pragma unroll
                for (int k = 0; k < 4; ++k) s5_bu(P, us + (tb + t + k) * 16, br4[k], bi4[k]);
#pragma unroll
                for (int k = 0; k < 4; ++k) { s5_rec(P, br4[k], bi4[k], hr, hi); Hs[(t + k) * 68 + lane] = pk2(hr, hi); } }
            LDS_WAIT();
            f32x4 Y = (f32x4){0.f, 0.f, 0.f, 0.f};
#pragma unroll
            for (int ks = 0; ks < 4; ++ks) { const bf16x8 af = __builtin_bit_cast(bf16x8, *(const LAS u32x4*)(Hs + fr * 68 + 16 * ks + 4 * fq)); Y = __builtin_amdgcn_mfma_f32_16x16x32_bf16(af, Bf[ks], Y, 0, 0, 0); }
#pragma unroll
            for (int jj = 0; jj < 4; ++jj) { const int t = tb + 4 * fq + jj; const float yv = Y[jj] + dsk * us[t * 16 + fr];
                Gt[t * 264 + g * 16 + fr] = (bf16)f2bf(gelu_tanh(yv)); }
            LDS_WAIT();
        }
    }
    __syncthreads();
    { const bf16* wg = (const bf16*)(a.ws + WS_WGLU) + (size_t)l * 256 * 256;
        f32x4 acc[4][2];
#pragma unroll
        for (int rb = 0; rb < 4; ++rb)
#pragma unroll
            for (int cbk = 0; cbk < 2; ++cbk) acc[rb][cbk] = (f32x4){0.f, 0.f, 0.f, 0.f};
#pragma unroll 2
        for (int ks = 0; ks < 8; ++ks) {
            bf16x8 bfr[2];
#pragma unroll
            for (int cbk = 0; cbk < 2; ++cbk) bfr[cbk] = *(const bf16x8*)(wg + (size_t)(32 * wave + 16 * cbk + fr) * 256 + 32 * ks + 8 * fq);
#pragma unroll
            for (int rb = 0; rb < 4; ++rb) { const bf16x8 af = *(const LAS bf16x8*)(Gt + (16 * rb + fr) * 264 + 32 * ks + 8 * fq);
#pragma unroll
                for (int cbk = 0; cbk < 2; ++cbk) acc[rb][cbk] = __builtin_amdgcn_mfma_f32_16x16x32_bf16(af, bfr[cbk], acc[rb][cbk], 0, 0, 0); }
        }
#pragma unroll
        for (int rb = 0; rb < 4; ++rb)
#pragma unroll
            for (int cbk = 0; cbk < 2; ++cbk)
#pragma unroll
                for (int jj = 0; jj < 4; ++jj) { const int t = 16 * rb + 4 * fq + jj, n = 32 * wave + 16 * cbk + fr;
                    const float gv = bf2f(Gt[t * 264 + n]);
                    y[((size_t)b * T + tc0 + t) * D + 256 + n] = (bf16)f2bf(gv * sigmoidf_(acc[rb][cbk][jj])); }
    }
    __syncthreads();
}

#define MFMA32(a, b, c) __builtin_amdgcn_mfma_f32_32x32x16_bf16((a), (b), (c), 0, 0, 0)
DI void ld_frag4(bf16x8 (&f)[4], const bf16* rowp, int h) {
#pragma unroll
    for (int s = 0; s < 4; ++s) f[s] = *(const bf16x8*)(rowp + 16 * s + 8 * h);
}
DI bf16x8 pack8(const float* p) { u32x4 w; w.x = pk2(p[0], p[1]); w.y = pk2(p[2], p[3]); w.z = pk2(p[4], p[5]); w.w = pk2(p[6], p[7]); return __builtin_bit_cast(bf16x8, w); }
DI f32x16 zero16() { f32x16 z;
#pragma unroll
    for (int i = 0; i < 16; ++i) z[i] = 0.f; return z; }

DI void sb_task(KArgsR a, int task, int lane) {
    const int qt = 255 - (task >> 4), b = (task >> 2) & 3, hd = task & 3;
    const bf16* z = (const bf16*)(a.ws + WS_Z); bf16* y = (bf16*)(a.ws + WS_Y);
    const int q = lane & 31, h = lane >> 5, t0 = qt * 32, t = t0 + q;
    bf16x8 Qf[4]; ld_frag4(Qf, z + ((size_t)b * T + t) * NZ + ZC_SBQ + hd * 64, h);
    const bf16* kfb = (const bf16*)((unsigned char*)a.out + OB_KFSB) + (size_t)(b * 4 + hd) * T * 64 + (size_t)lane * 8;
    const bf16* vfb = (const bf16*)((unsigned char*)a.out + OB_VFSB) + (size_t)(b * 4 + hd) * T * 64 + (size_t)lane * 8;
    f32x16 O0 = zero16(), O1 = zero16();
    float A = 0.f;
    bf16x8 Kn[4], Vn[4];
#pragma unroll
    for (int f = 0; f < 4; ++f) { Kn[f] = *(const bf16x8*)(kfb + (size_t)(qt * 4 + f) * 512); Vn[f] = *(const bf16x8*)(vfb + (size_t)(qt * 4 + f) * 512); }
    for (int kt = qt; kt >= 0; --kt) {
        const int key0 = kt * 32;
        bf16x8 Kf[4], V0[2], V1[2];
#pragma unroll
        for (int f = 0; f < 4; ++f) Kf[f] = Kn[f];
        V0[0] = Vn[0]; V0[1] = Vn[1]; V1[0] = Vn[2]; V1[1] = Vn[3];
        if (kt > 0) {
#pragma unroll
            for (int f = 0; f < 4; ++f) { Kn[f] = *(const bf16x8*)(kfb + (size_t)((kt - 1) * 4 + f) * 512); Vn[f] = *(const bf16x8*)(vfb + (size_t)((kt - 1) * 4 + f) * 512); } }
        f32x16 S = zero16();
#pragma unroll
        for (int s = 0; s < 4; ++s) S = MFMA32(Kf[s], Qf[s], S);
        float ls[16], lk[16];
#pragma unroll
        for (int i = 0; i < 16; ++i) { const int key = key0 + crow(i, h); const bool valid = key < t;
            const float zz = S[i] * 0.125f; const float e = fexp2(-fabsf(zz) * LOG2E); const float l1p = __builtin_amdgcn_logf(1.f + e) * LN2;
            ls[i] = fminf(zz, 0.f) - l1p;
            lk[i] = valid ? (ls[i] - zz) : 0.f; }
        float Gs[4], Gp[4];
#pragma unroll
        for (int g4 = 0; g4 < 4; ++g4) { Gs[g4] = (lk[4 * g4] + lk[4 * g4 + 1]) + (lk[4 * g4 + 2] + lk[4 * g4 + 3]); Gp[g4] = __shfl_xor(Gs[g4], 32); }
        float w[16]; float after = 0.f;
#pragma unroll
        for (int g4 = 3; g4 >= 0; --g4) {
            const float base = A + after + (h == 0 ? Gp[g4] : 0.f);
            float suf = 0.f;
#pragma unroll
            for (int jj = 3; jj >= 0; --jj) { const int i = 4 * g4 + jj; const int key = key0 + crow(i, h);
                const float lw = ls[i] + base + suf; w[i] = (key < t) ? fexp2(lw * LOG2E) : 0.f; suf += lk[i]; }
            after += Gs[g4] + Gp[g4];
        }
        A += after;
        const bf16x8 P0 = pack8(w), P1 = pack8(w + 8);
        O0 = MFMA32(V0[0], P0, O0); O0 = MFMA32(V0[1], P1, O0); O1 = MFMA32(V1[0], P0, O1); O1 = MFMA32(V1[1], P1, O1);
        if (__all(A < -40.f)) break;
    }
    bf16* yo = y + ((size_t)b * T + t) * D + 512 + hd * 64;
#pragma unroll
    for (int g4 = 0; g4 < 4; ++g4) { u32x2 w0, w1; w0.x = pk2(O0[4 * g4], O0[4 * g4 + 1]); w0.y = pk2(O0[4 * g4 + 2], O0[4 * g4 + 3]); w1.x = pk2(O1[4 * g4], O1[4 * g4 + 1]); w1.y = pk2(O1[4 * g4 + 2], O1[4 * g4 + 3]);
        *(u32x2*)(yo + 8 * g4 + 4 * h) = w0; *(u32x2*)(yo + 32 + 8 * g4 + 4 * h) = w1; }
}

DI unsigned wave_or(unsigned v) {
#pragma unroll
    for (int o = 1; o < 64; o <<= 1) v |= (unsigned)__shfl_xor((int)v, o);
    return v;
}
DI void nsa_block(KArgsR a, int l, int qs, int combo, LAS unsigned char* lds, LAS int* lc, int tid_in, int lane_in, int wave) {
    int tid = tid_in; asm volatile("" : "+v"(tid)); const int lane = tid & 63; (void)lane_in;
    const int b = (combo >> 2) & 3, g = (combo >> 1) & 1, hd_task = combo & 1;
    const bf16* z = (const bf16*)(a.ws + WS_Z); bf16* y = (bf16*)(a.ws + WS_Y);
    LAS float* U = (LAS float*)(lds + wave * 16384);
    const int q = lane & 31, h = lane >> 5, qt = 8 * qs + wave, t0 = qt * 32, t = t0 + q, cur = t0 >> 6;
    const size_t rowq = (size_t)b * T + t;
    const float bq = wave_max(fabsf(((const float*)a.in[I_QNG])[l * 64 + lane])), bk = wave_max(fabsf(((const float*)a.in[I_KNG])[l * 64 + lane]));
    const float c1 = 0.125f * LOG2E, c2 = 8.f * bq * bk * LOG2E;
    for (int i = lane; i < 1024; i += 64) ((LAS f32x4*)U)[i] = (f32x4){0.f, 0.f, 0.f, 0.f};
    if (tid < 4) lc[LC_UNI + tid] = 0;
    __syncthreads();
    const int imq = (t >= 31) ? ((t - 31) >> 4) : -1;
    const int ntc = (qs >> 1) + 1;
    const bf16* kcf = (const bf16*)(a.ws + WS_KC) + (size_t)(b * 2 + g) * 512 * 64 + (size_t)lane * 8;
    const bf16* vcf = (const bf16*)(a.ws + WS_VCT) + (size_t)(b * 2 + g) * 512 * 64 + (size_t)lane * 8;
    const int nfull_c = (qt > 0) ? ((((32 * qt - 31) >> 4) + 1) >> 5) : 0;
    float inv[2];
    {
        bf16x8 Qf[2][4];
#pragma unroll
        for (int hd = 0; hd < 2; ++hd) ld_frag4(Qf[hd], z + rowq * NZ + ZC_NQ + (2 * g + hd) * 64, h);
        float lsum[2] = {0.f, 0.f};
        bf16x8 Kn[4];
#pragma unroll
        for (int f = 0; f < 4; ++f) Kn[f] = *(const bf16x8*)(kcf + (size_t)f * 512);
#pragma unroll 1
        for (int it = 0; it < ntc; ++it) {
            bf16x8 Kf[4];
#pragma unroll
            for (int f = 0; f < 4; ++f) Kf[f] = Kn[f];
            if (it + 1 < ntc) {
#pragma unroll
                for (int f = 0; f < 4; ++f) Kn[f] = *(const bf16x8*)(kcf + (size_t)((it + 1) * 4 + f) * 512); }
#pragma unroll
            for (int hd = 0; hd < 2; ++hd) { f32x16 S = zero16();
#pragma unroll
                for (int s = 0; s < 4; ++s) S = MFMA32(Kf[s], Qf[hd][s], S);
                if (it < nfull_c) {
#pragma unroll
                    for (int i = 0; i < 16; ++i) lsum[hd] += fexp2(S[i] * c1 - c2);
                } else {
#pragma unroll
                    for (int i = 0; i < 16; ++i) { const int key = 32 * it + crow(i, h); lsum[hd] += (key <= imq) ? fexp2(S[i] * c1 - c2) : 0.f; } } }
        }
#pragma unroll
        for (int hd = 0; hd < 2; ++hd) { const float s = lsum[hd] + __shfl_xor(lsum[hd], 32); inv[hd] = (s > 0.f) ? 1.f / s : 0.f; }
        float carry[2] = {0.f, 0.f};
#pragma unroll
        for (int f = 0; f < 4; ++f) Kn[f] = *(const bf16x8*)(kcf + (size_t)f * 512);
#pragma unroll 1
        for (int it = 0; it < ntc; ++it) {
            bf16x8 Kf[4];
#pragma unroll
            for (int f = 0; f < 4; ++f) Kf[f] = Kn[f];
            if (it + 1 < ntc) {
#pragma unroll
                for (int f = 0; f < 4; ++f) Kn[f] = *(const bf16x8*)(kcf + (size_t)((it + 1) * 4 + f) * 512); }
#pragma unroll
            for (int hd = 0; hd < 2; ++hd) { f32x16 S = zero16();
#pragma unroll
                for (int s = 0; s < 4; ++s) S = MFMA32(Kf[s], Qf[hd][s], S);
                float p[16];
#pragma unroll
                for (int i = 0; i < 16; ++i) { const int key = 32 * it + crow(i, h); p[i] = (key <= imq) ? fexp2(S[i] * c1 - c2) * inv[hd] : 0.f; }
                float bnd[4];
#pragma unroll
                for (int g4 = 0; g4 < 4; ++g4) bnd[g4] = __shfl_xor(p[4 * g4 + 3], 32);
#pragma unroll
                for (int g4 = 0; g4 < 4; ++g4) { const float G4 = (p[4 * g4] + p[4 * g4 + 1]) + (p[4 * g4 + 2] + p[4 * g4 + 3]);
                    const float extra = h ? bnd[g4] : (g4 ? bnd[g4 > 0 ? g4 - 1 : 0] : carry[hd]);
                    const int sblk = 8 * it + 2 * g4 + h; U[sblk * 32 + q] += G4 + extra; }
                carry[hd] = bnd[3]; }
        }
    }
    unsigned m0 = 0, m1 = 0, m2 = 0, m3 = 0;
    int tsel = tid; asm volatile("" : "+v"(tsel)); const int qsl = tsel & 31, hsl = (tsel >> 5) & 1;
#define SETBIT(idx) do { const int _i = (idx); const unsigned _b = 1u << (_i & 31); const int _w = _i >> 5; m0 |= (_w == 0) ? _b : 0u; m1 |= (_w == 1) ? _b : 0u; m2 |= (_w == 2) ? _b : 0u; m3 |= (_w == 3) ? _b : 0u; } while (0)
    if (cur <= 15) { m0 = (2u << cur) - 1u; }
    else {
        SETBIT(0); SETBIT(cur - 1); SETBIT(cur);
        const int mid = (cur + 1) >> 1; const int lo = hsl ? mid : 1, hi_ = hsl ? cur - 1 : mid;
#pragma unroll 1
        for (int r = 0; r < 13; ++r) {
            float bv = -2.f; int bi = 1 << 20;
#pragma unroll 8
            for (int s = lo; s < hi_; ++s) { const float v = U[s * 32 + qsl]; if (v > bv) { bv = v; bi = s; } }
            const float pv = __shfl_xor(bv, 32); const int pi = __shfl_xor(bi, 32);
            const bool takep = (pv > bv) || (pv == bv && pi < bi);
            const int wi = takep ? pi : bi;
            if (!takep) U[wi * 32 + qsl] = -1.f;
            SETBIT(wi);
        }
    }
#undef SETBIT
    const unsigned u0 = __builtin_amdgcn_readfirstlane(wave_or(m0)), u1 = __builtin_amdgcn_readfirstlane(wave_or(m1)), u2 = __builtin_amdgcn_readfirstlane(wave_or(m2)), u3 = __builtin_amdgcn_readfirstlane(wave_or(m3));
    if (lane == 0) { __hip_atomic_fetch_or((LAS unsigned*)&lc[LC_UNI + 0], u0, __ATOMIC_RELAXED, __HIP_MEMORY_SCOPE_WORKGROUP); __hip_atomic_fetch_or((LAS unsigned*)&lc[LC_UNI + 1], u1, __ATOMIC_RELAXED, __HIP_MEMORY_SCOPE_WORKGROUP);
        __hip_atomic_fetch_or((LAS unsigned*)&lc[LC_UNI + 2], u2, __ATOMIC_RELAXED, __HIP_MEMORY_SCOPE_WORKGROUP); __hip_atomic_fetch_or((LAS unsigned*)&lc[LC_UNI + 3], u3, __ATOMIC_RELAXED, __HIP_MEMORY_SCOPE_WORKGROUP); }
    __syncthreads();
    if (tid < 128) {
        const unsigned w0 = (unsigned)lc[LC_UNI + 0], w1 = (unsigned)lc[LC_UNI + 1], w2 = (unsigned)lc[LC_UNI + 2], w3 = (unsigned)lc[LC_UNI + 3];
        const int wd = tid >> 5, bit = tid & 31; const unsigned uw = (wd == 0) ? w0 : (wd == 1) ? w1 : (wd == 2) ? w2 : w3;
        const int below = (wd > 0 ? __builtin_popcount(w0) : 0) + (wd > 1 ? __builtin_popcount(w1) : 0) + (wd > 2 ? __builtin_popcount(w2) : 0) + __builtin_popcount(uw & ((1u << bit) - 1u));
        if ((uw >> bit) & 1u) lc[LC_BLIST + below] = tid;
        if (tid == 0) lc[LC_UNI + 4] = __builtin_popcount(w0) + __builtin_popcount(w1) + __builtin_popcount(w2) + __builtin_popcount(w3); }
    __syncthreads();
    const int nblk = __builtin_amdgcn_readfirstlane(lc[LC_UNI + 4]);
    { const int hd = hd_task;
        const int head = 2 * g + hd;
        int tl = tid; asm volatile("" : "+v"(tl));
        const int ql = tl & 31, hl = (tl >> 5) & 1; const size_t rowq2 = (size_t)b * T + t0 + ql;
        bf16x8 Qf[4]; ld_frag4(Qf, z + rowq2 * NZ + ZC_NQ + head * 64, hl);
        const float* glp = (const float*)(a.ws + WS_GL) + rowq2 * 12 + head * 3;
        const float gc = sigmoidf_(glp[0]), gs = sigmoidf_(glp[1]), gw = sigmoidf_(glp[2]);
        f32x16 F0, F1;
        {
            LAS float* slots = (LAS float*)lds;
            LAS int* cntj = (LAS int*)(lds + 69632);
            LAS int* ibj = (LAS int*)(lds + 70144);
            LAS unsigned char* qlist = lds + 70656;
            LAS unsigned short* tab = (LAS unsigned short*)(lds + 103424);
            LAS unsigned char* Qs = lds + 111616;
            if (tid < 128) cntj[tid] = 0;
#pragma unroll
            for (int sv = 0; sv < 4; ++sv) *(LAS bf16x8*)(Qs + (wave * 32 + ql) * 144 + (16 * sv + 8 * hl) * 2) = Qf[sv];
            __syncthreads();
            int ncon = 0;
            { const int qloc = wave * 32 + ql;
#pragma unroll 1
                for (int wd = 0; wd < 4; ++wd) { unsigned mm = (wd == 0) ? m0 : (wd == 1) ? m1 : (wd == 2) ? m2 : m3;
                    while (mm) { const int bit = __builtin_ctz(mm); mm &= mm - 1u; const int j = wd * 32 + bit;
                        if (hl == 0) { const int pos = __hip_atomic_fetch_add(&cntj[j], 1, __ATOMIC_RELAXED, __HIP_MEMORY_SCOPE_WORKGROUP); qlist[j * 256 + pos] = (unsigned char)qloc; tab[qloc * 16 + ncon] = (unsigned short)(j | (pos << 7)); }
                        ++ncon; } } }
            __syncthreads();
            {
                int ng = 0, jb = 0, cjb = 0;
                if (tid < 128 && tid < nblk) { jb = lc[LC_BLIST + tid]; cjb = cntj[jb]; ng = (cjb + 31) >> 5; }
                int incl = ng;
#pragma unroll
                for (int o = 1; o < 64; o <<= 1) { const int v = __shfl_up(incl, o); if ((tl & 63) >= o) incl += v; }
                if (tid == 63) lc[LC_UNI + 7] = incl;
                __syncthreads();
                if (tid < 128) { const int base = incl - ng + ((tid >= 64) ? lc[LC_UNI + 7] : 0);
                    if (tid < nblk) { ibj[jb] = base; for (int k = 0; k < ng; ++k) lc[LC_ITEMS + base + k] = jb | ((32 * k) << 8); }
                    if (tid == 127) lc[LC_UNI + 5] = base + ng; }
            }
            __syncthreads();
            const int nitems = __builtin_amdgcn_readfirstlane(lc[LC_UNI + 5]); const int lane6 = tl & 63; const int nrounds = (nitems + 7) >> 3;
            const bf16* kfb = (const bf16*)((unsigned char*)a.out + OB_KFSLC) + (size_t)(b * 2 + g) * T * 64 + (size_t)lane6 * 8;
            const bf16* vfb = (const bf16*)((unsigned char*)a.out + OB_VFSLC) + (size_t)(b * 2 + g) * T * 64 + (size_t)lane6 * 8;
#define NSA_LDT(ktg) do { _Pragma("unroll") for (int f_ = 0; f_ < 4; ++f_) { Kn[f_] = *(const bf16x8*)(kfb + (size_t)((ktg) * 4 + f_) * 512); Vn[f_] = *(const bf16x8*)(vfb + (size_t)((ktg) * 4 + f_) * 512); } } while (0)
            bf16x8 Kn[4], Vn[4];
            if (wave < nitems) { const int j0 = __builtin_amdgcn_readfirstlane(lc[LC_ITEMS + wave]) & 255; NSA_LDT(2 * j0); }
            int kcur = 0; float lacc = 0.f;
#pragma unroll
            for (int i = 0; i < 16; ++i) { F0[i] = 0.f; F1[i] = 0.f; }
            const int qown = wave * 32 + ql;
#pragma unroll 1
            for (int r = 0; r < nrounds; ++r) {
                const int it = 8 * r + wave;
                if (it < nitems) {
                    const int itm = __builtin_amdgcn_readfirstlane(lc[LC_ITEMS + it]); const int j = itm & 255, g0 = itm >> 8; const int cj = __builtin_amdgcn_readfirstlane(cntj[j]);
                    const int idx = g0 + ql; const bool valid = idx < cj; const int qloc = qlist[j * 256 + (valid ? idx : g0)];
                    const int tq = 256 * qs + qloc;
                    bf16x8 Qg[4];
#pragma unroll
                    for (int sv = 0; sv < 4; ++sv) Qg[sv] = *(const LAS bf16x8*)(Qs + qloc * 144 + (16 * sv + 8 * hl) * 2);
                    f32x16 O0 = zero16(), O1 = zero16(); float ls = 0.f;
#pragma unroll
                    for (int kt = 0; kt < 2; ++kt) { const int key0 = 64 * j + 32 * kt;
                        bf16x8 Kf[4], Vf[4];
#pragma unroll
                        for (int f = 0; f < 4; ++f) { Kf[f] = Kn[f]; Vf[f] = Vn[f]; }
                        if (kt == 0) { NSA_LDT(2 * j + 1); }
                        else if (it + 8 < nitems) { const int jn = __builtin_amdgcn_readfirstlane(lc[LC_ITEMS + it + 8]) & 255; NSA_LDT(2 * jn); }
                        f32x16 S = zero16();
#pragma unroll
                        for (int sv = 0; sv < 4; ++sv) S = MFMA32(Kf[sv], Qg[sv], S);
                        float p[16];
#pragma unroll
                        for (int i = 0; i < 16; ++i) { const int key = key0 + crow(i, hl); p[i] = (valid && key <= tq) ? fexp2(S[i] * c1 - c2) : 0.f; ls += p[i]; }
                        const bf16x8 P0 = pack8(p), P1 = pack8(p + 8);
                        O0 = MFMA32(Vf[0], P0, O0); O0 = MFMA32(Vf[1], P1, O0); O1 = MFMA32(Vf[2], P0, O1); O1 = MFMA32(Vf[3], P1, O1); }
                    ls += __shfl_xor(ls, 32);
                    LAS float* sl = slots + (wave * 32 + ql) * 68;
#pragma unroll
                    for (int g4 = 0; g4 < 4; ++g4) { *(LAS f32x4*)(sl + 8 * g4 + 4 * hl) = (f32x4){O0[4 * g4], O0[4 * g4 + 1], O0[4 * g4 + 2], O0[4 * g4 + 3]};
                        *(LAS f32x4*)(sl + 32 + 8 * g4 + 4 * hl) = (f32x4){O1[4 * g4], O1[4 * g4 + 1], O1[4 * g4 + 2], O1[4 * g4 + 3]}; }
                    if (hl == 0) sl[64] = ls;
                }
                __syncthreads();
                while (kcur < ncon) {
                    const int e = tab[qown * 16 + kcur]; const int j = e & 127, pos = e >> 7; const int item = ibj[j] + (pos >> 5);
                    if ((item >> 3) != r) break;
                    const LAS float* sl = slots + ((item & 7) * 32 + (pos & 31)) * 68;
#pragma unroll
                    for (int g4 = 0; g4 < 4; ++g4) { const f32x4 v0 = *(const LAS f32x4*)(sl + 8 * g4 + 4 * hl), v1 = *(const LAS f32x4*)(sl + 32 + 8 * g4 + 4 * hl);
#pragma unroll
                        for (int jj = 0; jj < 4; ++jj) { F0[4 * g4 + jj] += v0[jj]; F1[4 * g4 + jj] += v1[jj]; } }
                    lacc += sl[64]; ++kcur;
                }
                __syncthreads();
            }
#undef NSA_LDT
            { const float scl = gs / lacc; F0 = F0 * scl; F1 = F1 * scl; }
        }
        {
            f32x16 O0 = zero16(), O1 = zero16(); float ls = 0.f;
            bf16x8 Kn[4], Vn[4];
#pragma unroll
            for (int f = 0; f < 4; ++f) { Kn[f] = *(const bf16x8*)(kcf + (size_t)f * 512); Vn[f] = *(const bf16x8*)(vcf + (size_t)f * 512); }
#pragma unroll 1
            for (int it = 0; it < ntc; ++it) {
                bf16x8 Kf[4], Vf[4];
#pragma unroll
                for (int f = 0; f < 4; ++f) { Kf[f] = Kn[f]; Vf[f] = Vn[f]; }
                if (it + 1 < ntc) {
#pragma unroll
                    for (int f = 0; f < 4; ++f) { Kn[f] = *(const bf16x8*)(kcf + (size_t)((it + 1) * 4 + f) * 512); Vn[f] = *(const bf16x8*)(vcf + (size_t)((it + 1) * 4 + f) * 512); } }
                f32x16 S = zero16();
#pragma unroll
                for (int sv = 0; sv < 4; ++sv) S = MFMA32(Kf[sv], Qf[sv], S);
                float p[16];
                if (it < nfull_c) {
#pragma unroll
                    for (int i = 0; i < 16; ++i) { p[i] = fexp2(S[i] * c1 - c2); ls += p[i]; }
                } else {
#pragma unroll
                    for (int i = 0; i < 16; ++i) { const int key = 32 * it + crow(i, hl); p[i] = (key <= imq) ? fexp2(S[i] * c1 - c2) : 0.f; ls += p[i]; }
                }
                const bf16x8 P0 = pack8(p), P1 = pack8(p + 8);
                O0 = MFMA32(Vf[0], P0, O0); O0 = MFMA32(Vf[1], P1, O0); O1 = MFMA32(Vf[2], P0, O1); O1 = MFMA32(Vf[3], P1, O1);
            }
            ls += __shfl_xor(ls, 32); const float scl = (ls > 0.f) ? gc / ls : 0.f;
            F0 += O0 * scl; F1 += O1 * scl;
        }
        {
            f32x16 O0 = zero16(), O1 = zero16(); float ls = 0.f;
            const int lane6 = tl & 63;
            const bf16* kfw = (const bf16*)((unsigned char*)a.out + OB_KFWIN) + (size_t)(b * 2 + g) * T * 64 + (size_t)lane6 * 8;
            const bf16* vfw = (const bf16*)((unsigned char*)a.out + OB_VFWIN) + (size_t)(b * 2 + g) * T * 64 + (size_t)lane6 * 8;
            int ktw = qt - 16; if (ktw < 0) ktw = 0;
            bf16x8 Kn[4], Vn[4];
#pragma unroll
            for (int f = 0; f < 4; ++f) { Kn[f] = *(const bf16x8*)(kfw + (size_t)(ktw * 4 + f) * 512); Vn[f] = *(const bf16x8*)(vfw + (size_t)(ktw * 4 + f) * 512); }
#pragma unroll 1
            for (int kt = ktw; kt <= qt; ++kt) {
                bf16x8 Kf[4], Vf[4];
#pragma unroll
                for (int f = 0; f < 4; ++f) { Kf[f] = Kn[f]; Vf[f] = Vn[f]; }
                if (kt < qt) {
#pragma unroll
                    for (int f = 0; f < 4; ++f) { Kn[f] = *(const bf16x8*)(kfw + (size_t)((kt + 1) * 4 + f) * 512); Vn[f] = *(const bf16x8*)(vfw + (size_t)((kt + 1) * 4 + f) * 512); } }
                f32x16 S = zero16();
#pragma unroll
                for (int sv = 0; sv < 4; ++sv) S = MFMA32(Kf[sv], Qf[sv], S);
                float p[16];
                if (kt > qt - 16 && kt < qt) {
#pragma unroll
                    for (int i = 0; i < 16; ++i) { p[i] = fexp2(S[i] * c1 - c2); ls += p[i]; }
                } else {
#pragma unroll
                    for (int i = 0; i < 16; ++i) { const int key = 32 * kt + crow(i, hl); p[i] = (key <= t && key > t - 512) ? fexp2(S[i] * c1 - c2) : 0.f; ls += p[i]; }
                }
                const bf16x8 P0 = pack8(p), P1 = pack8(p + 8);
                O0 = MFMA32(Vf[0], P0, O0); O0 = MFMA32(Vf[1], P1, O0); O1 = MFMA32(Vf[2], P0, O1); O1 = MFMA32(Vf[3], P1, O1);
            }
            ls += __shfl_xor(ls, 32); const float scl = gw / ls;
            F0 += O0 * scl; F1 += O1 * scl;
        }
        bf16* yo = y + rowq2 * D + 768 + head * 64;
#pragma unroll
        for (int g4 = 0; g4 < 4; ++g4) { u32x2 w0, w1; w0.x = pk2(F0[4 * g4], F0[4 * g4 + 1]); w0.y = pk2(F0[4 * g4 + 2], F0[4 * g4 + 3]); w1.x = pk2(F1[4 * g4], F1[4 * g4 + 1]); w1.y = pk2(F1[4 * g4 + 2], F1[4 * g4 + 3]);
            *(u32x2*)(yo + 8 * g4 + 4 * h) = w0; *(u32x2*)(yo + 32 + 8 * g4 + 4 * h) = w1; }
    }
    __syncthreads();
}
__device__ __attribute__((noinline)) void grid_bar_call(unsigned* bar, volatile LAS unsigned* st) { XcdBarrier b_; b_.bar = bar; b_.x = xb_xcc_id(); b_.st = st; xcd_barrier(b_); }
constexpr int DEPTH = 2;
typedef const __attribute__((address_space(4))) Args* KArgsP;
__global__ void __launch_bounds__(512, 2) fwd_kernel(Args a_in) {
    extern __shared__ __attribute__((aligned(16))) unsigned char lds_raw[];
    LAS unsigned char* lds = (LAS unsigned char*)lds_raw;
    int tid = threadIdx.x, lane = tid & 63; const int wave = __builtin_amdgcn_readfirstlane(tid >> 6), G = gridDim.x;
    LAS int* lc = (LAS int*)(lds + LDSCTL_OFF);
#define PHASE() tid = threadIdx.x; asm volatile("" : "+v"(tid)); lane = tid & 63; KArgsP kp_ = (KArgsP)__builtin_amdgcn_kernarg_segment_ptr(); asm volatile("" : "+s"(kp_)); KArgsR a = *kp_; \
    gu32* ctl = (gu32*)(a.ws + WS_CTL); f16* h = (f16*)(a.ws + WS_H16); const float* modl = (const float*)(a.ws + WS_MOD) + l * 4 * 6144; (void)ctl; (void)modl; (void)h
#define GRID_BAR() do { CODE_WARM(); KArgsP kb_ = (KArgsP)__builtin_amdgcn_kernarg_segment_ptr(); asm volatile("" : "+s"(kb_)); grid_bar_call((unsigned*)(kb_->ws + WS_CTL) + CW_BAR, (volatile LAS unsigned*)(lc + LC_BAR)); } while (0)
#ifdef TP
    const unsigned long long t_start = __builtin_amdgcn_s_memrealtime();
#define TPOINT(k) do { if (TP == (k) && l == TPL) { while (__builtin_amdgcn_s_memrealtime() - t_start < 600000ull) __builtin_amdgcn_s_sleep(8); } } while (0)
#else
#define TPOINT(k) do { } while (0)
#endif
    for (int u = tid; u < (LDS_BYTES - LDSCTL_OFF) / 4; u += 512) lc[u] = 0;
    __syncthreads();
#ifdef CODE_WARM_N
    { const unsigned long long pc0 = __builtin_amdgcn_s_getpc(); if (tid == 0) { lc[LC_MISC + 4] = (int)(unsigned)pc0; lc[LC_MISC + 5] = (int)(unsigned)(pc0 >> 32); } __syncthreads(); }
#define CODE_WARM() do { if (wave == 1) { const unsigned* cp_ = (const unsigned*)((((unsigned long long)(unsigned)lc[LC_MISC + 4]) | ((unsigned long long)(unsigned)lc[LC_MISC + 5] << 32)) & ~127ull) + lane * 32; unsigned x_ = 0; \
        _Pragma("unroll") for (int k_ = 0; k_ < CODE_WARM_N; ++k_) x_ ^= cp_[k_ * 2048]; if (x_ == 0x9e3779b9u) lc[LC_MISC + 6] = 1; } } while (0)
#else
#define CODE_WARM() do { } while (0)
#endif
    { const int l = 0; PHASE(); (void)xcd_barrier_post((unsigned*)(a.ws + WS_CTL) + CW_BAR, (volatile LAS unsigned*)(lc + LC_BAR));
      prologue(a, lds, tid, lane, wave, G);
    }
    GRID_BAR();

    for (int l = 0; l < DEPTH; ++l) {
        const int dense = (l == 0);
        TPOINT(0);
        { PHASE();
          if (l == 0) norm_phase<12, false>(a, a.in[I_X], (const float*)a.in[I_NMG] + l * D, modl, 0, (const float*)a.in[I_WIN] + (size_t)l * D * NIN + NZ, NIN, lds, tid, lane, wave, G);
          else norm_phase<12, true>(a, h, (const float*)a.in[I_NMG] + l * D, modl, 0, (const float*)a.in[I_WIN] + (size_t)l * D * NIN + NZ, NIN, lds, tid, lane, wave, G); }
        GRID_BAR();
        TPOINT(10);
        { PHASE();
          pg8::Gemm g{(const bf16*)((unsigned char*)a.out + OB_A), (const bf16*)(a.ws + WS_WIN) + (size_t)l * NZ * D, M, NZ, D}; pg8::StaticOrder S; S.init(M, NZ, D, G, (int)blockIdx.x);
          EpiZ E{(bf16*)(a.ws + WS_Z)};
          pg8::gemm_phase<EpiZ, pg8::StaticOrder, true, false>(lds, g, S, E); }
        GRID_BAR();
        TPOINT(1);
#ifdef REP_CMP
        { PHASE(); for (int rep_ = 0; rep_ < REP_CMP; ++rep_) { asm volatile("" : "+v"(tid)); for (int task = blockIdx.x; task < 256; task += G) cmp_task(a, l, task, lds, tid, lane, wave); } }
#else
        { PHASE(); for (int task = blockIdx.x; task < 256; task += G) cmp_task(a, l, task, lds, tid, lane, wave); }
#endif
#ifdef DBL_CMP
        { PHASE(); for (int task = blockIdx.x; task < 256; task += G) cmp_task(a, l, task, lds, tid, lane, wave); }
#endif
        TPOINT(2);
        { PHASE(); for (int task = blockIdx.x; task < 512; task += G) s5_pass1(a, l, task >> 7, task & 127, lds, tid, lane, wave); }
        TPOINT(3);
        { PHASE(); for (int task = blockIdx.x; task < 512; task += G) { const int b = task >> 7, t0 = (task & 127) * 64; conv_tile(a, l, b, t0, tid); prep_tile(a, l, b, t0, lds, tid, lane, wave); } }
        GRID_BAR();
        TPOINT(4);
        { PHASE(); for (int bg = (int)blockIdx.x * 8 + wave; bg < 64; bg += G * 8) s5_carry(a, l, bg, lane, ctl + CW_S5F + 64 * l); }
        { PHASE(); for (int pr = blockIdx.x; pr < 256; pr += G) {
#pragma unroll 1
              for (int half = 0; half < 2; ++half) nsa_block(a, l, half ? (pr >> 4) : 31 - (pr >> 4), pr & 15, lds, lc, tid, lane, wave); } }
        TPOINT(5);
        { PHASE(); s5_carry_wait(ctl + CW_S5F + 64 * l, tid); for (int task = blockIdx.x; task < 512; task += G) s5_pass2(a, l, task >> 7, task & 127, lds, tid, lane, wave); }
        TPOINT(6);
        { PHASE(); for (int task = (int)blockIdx.x * 8 + wave; task < 4096; task += G * 8) sb_task(a, task, lane); }
        GRID_BAR();
        TPOINT(7);
        { PHASE();
          pg8::Gemm g{(const bf16*)(a.ws + WS_Y), (const bf16*)(a.ws + WS_WOUT) + (size_t)l * D * D, M, D, D}; pg8::StaticOrder S; S.init(M, D, D, G, (int)blockIdx.x);
          EpiRes E{l == 0 ? (const float*)a.in[I_X] : nullptr, h, modl};
          pg8::gemm_phase<EpiRes, pg8::StaticOrder, true, false>(lds, g, S, E); }
        GRID_BAR();
        TPOINT(8);
        { PHASE();
          if (dense) { norm_phase<0, true>(a, h, (const float*)a.in[I_NFG] + l * D, modl, 3072, nullptr, 0, lds, tid, lane, wave, G); }
          else { norm_phase<8, true>(a, h, (const float*)a.in[I_NFG] + l * D, modl, 3072, (const float*)a.in[I_MR], 8, lds, tid, lane, wave, G); } }
        GRID_BAR();
        TPOINT(9);
        const int npass = dense ? 1 : 2;
        for (int kp = 0; kp < npass; ++kp) {
            int nRT;
            { PHASE();
              if (tid == 0) {
                int rt = 0;
                if (dense) rt = 128;
                else for (int e = 0; e < 8; ++e) { const int c = (int)__hip_atomic_load(ctl + CW_CNT + (kp * 8 + e) * 64, RLX_AGENT); lc[LC_CNT + e] = c; const int nt_ = (c + 255) >> 8;
                    for (int i = 0; i < nt_; ++i) lc[LC_TILE + rt + i] = e | (i << 8); rt += nt_; }
                lc[LC_MISC] = rt;
              }
              __syncthreads();
              nRT = __builtin_amdgcn_readfirstlane(lc[LC_MISC]); }
            { PHASE(); const int* list = (const int*)(a.ws + WS_LIST) + (size_t)kp * 8 * 32768;
              pg8::Gemm g{(const bf16*)((unsigned char*)a.out + OB_A), dense ? (const bf16*)(a.ws + WS_WGUD) : (const bf16*)(a.ws + WS_WGUM), M, 7168, D};
              pg8::MoeOrder S; S.nRT = nRT; S.nN = 28; S.nwg = nRT * 28; S.G = G; S.c = (int)blockIdx.x; S.dense = dense; S.K2 = D * 2; S.tile_e = lc + LC_TILE; S.cnt = lc + LC_CNT; S.list = list; S.KT = D / 64; S.nfull = S.nwg; S.nsplit = 1;
              EpiSwiglu E{(bf16*)(a.ws + WS_HID)};
              pg8::gemm_phase<EpiSwiglu, pg8::MoeOrder, true, true>(lds, g, S, E); }
            GRID_BAR();
            int rem;
            { PHASE(); const int* list = (const int*)(a.ws + WS_LIST) + (size_t)kp * 8 * 32768;
              pg8::Gemm g{(const bf16*)(a.ws + WS_HID), dense ? (const bf16*)(a.ws + WS_WDD) : (const bf16*)(a.ws + WS_WDM), M, D, FF};
              pg8::MoeOrder S; S.nRT = nRT; S.nN = 4; S.nwg = nRT * 4; S.G = G; S.c = (int)blockIdx.x; S.dense = dense; S.K2 = FF * 2; S.tile_e = lc + LC_TILE; S.cnt = lc + LC_CNT; S.list = list;
              S.KT = FF / 64; S.nfull = (S.nwg / G) * G; S.nsplit = 7; rem = S.nwg - S.nfull; if (rem > 32) { S.nfull = S.nwg; rem = 0; }
              EpiDown E{h, a.out, modl, list, (const float*)(a.ws + WS_RTW), lc + LC_CNT, dense, kp, (l == DEPTH - 1 && kp == npass - 1) ? 1 : 0, (float*)(a.ws + WS_PART)};
              pg8::gemm_phase<EpiDown, pg8::MoeOrder, true, false>(lds, g, S, E); }
            if (rem > 0) {
                GRID_BAR();
                { PHASE(); const int* list = (const int*)(a.ws + WS_LIST) + (size_t)kp * 8 * 32768; const float* part = (const float*)(a.ws + WS_PART); const float* rtw = (const float*)(a.ws + WS_RTW);
                  pg8::MoeOrder S; S.nRT = nRT; S.nN = 4; S.nwg = nRT * 4; S.G = G; S.c = 0; S.dense = dense; S.K2 = 0; S.tile_e = lc + LC_TILE; S.cnt = lc + LC_CNT; S.list = list; S.KT = FF / 64; S.nfull = (S.nwg / G) * G; S.nsplit = 7;
                  for (int w = blockIdx.x * 8 + wave; w < rem * 256; w += G * 8) { const int ui = w >> 8, r = w & 255; pg8::Unit u; S.decode(S.nfull + ui, u);
                      const int idx = u.lt * 256 + r; int tok = idx; float wgt = 1.f; bool ok = true;
                      if (!dense) { ok = idx < lc[LC_CNT + u.e]; tok = ok ? list[u.e * 32768 + idx] : 0; wgt = ok ? rtw[tok * 2 + kp] : 0.f; }
                      if (ok) { f32x4 sum = (f32x4){0.f, 0.f, 0.f, 0.f};
#pragma unroll
                          for (int sp = 0; sp < 7; ++sp) sum += *(const f32x4*)(part + (size_t)(ui * 7 + sp) * 65536 + r * 256 + 4 * lane);
                          const int col = u.pl * 256 + 4 * lane; const int bb = tok >> 13; const f32x4 gv = *(const f32x4*)(modl + bb * 6144 + 5120 + col);
                          f16* hp = h + (size_t)tok * D + col; const u32x2 t = *(const u32x2*)hp; const f32x4 o = h4(t.x, t.y) + (gv * wgt) * sum;
                          if (l == DEPTH - 1 && kp == npass - 1) *(f32x4*)(a.out + (size_t)tok * D + col) = o; else { u32x2 wv; wv.x = pkh(o.x, o.y); wv.y = pkh(o.z, o.w); *(u32x2*)hp = wv; } } } }
            }
            GRID_BAR();
        }
    }
}

extern "C" void kernel_launch(void* const* d_in, const int* in_sizes, int n_in, void* d_out, int out_size, void* d_ws, size_t ws_size, hipStream_t stream) {
    static int grid = 0;
    if (grid == 0) {
        if (n_in != 34 || in_sizes[0] != M * D || out_size != M * D || ws_size < WS_END) { fprintf(stderr, "kernel_launch: unexpected shapes: n_in %d in0 %d out %d ws %zu (need %zu)\n", n_in, n_in > 0 ? in_sizes[0] : -1, out_size, ws_size, (size_t)WS_END); grid = -1; return; }
        int dev = 0, cus = 0, per_cu = 0;
        if (hipGetDevice(&dev) != hipSuccess || hipDeviceGetAttribute(&cus, hipDeviceAttributeMultiprocessorCount, dev) != hipSuccess) { grid = -1; return; }
        if (hipFuncSetAttribute((const void*)fwd_kernel, hipFuncAttributeMaxDynamicSharedMemorySize, LDS_BYTES) != hipSuccess) { fprintf(stderr, "kernel_launch: hipFuncSetAttribute failed\n"); grid = -1; return; }
        if (hipOccupancyMaxActiveBlocksPerMultiprocessor(&per_cu, (const void*)fwd_kernel, 512, LDS_BYTES) != hipSuccess || per_cu < 1) { fprintf(stderr, "kernel_launch: occupancy query says %d blocks per CU\n", per_cu); (void)hipGetLastError(); grid = -1; return; }
        grid = cus;
    }
    if (grid < 0) return;
    if (hipMemsetAsync((char*)d_ws + WS_CTL, 0, CTL_ZERO_BYTES, stream) != hipSuccess) return;
    Args a{};
    for (int i = 0; i < 34; ++i) a.in[i] = d_in[i];
    a.out = (float*)d_out; a.ws = (unsigned char*)d_ws;
    hipLaunchKernelGGL(fwd_kernel, dim3(grid), dim3(512), LDS_BYTES, stream, a);
}
```

```cpp
#define NORM_PF 1
#define CMP_WGS 128
#include <hip/hip_runtime.h>
#include <cstdio>
#include <cstdint>

#define LAS __attribute__((address_space(3)))
#define GAS __attribute__((address_space(1)))
typedef unsigned short bf16;
typedef short bf16x8 __attribute__((ext_vector_type(8)));
typedef short s16x4 __attribute__((ext_vector_type(4)));
typedef float f32x2 __attribute__((ext_vector_type(2)));
typedef float f32x4 __attribute__((ext_vector_type(4)));
typedef float f32x16 __attribute__((ext_vector_type(16)));
typedef unsigned u32x2 __attribute__((ext_vector_type(2)));
typedef unsigned u32x4 __attribute__((ext_vector_type(4)));
typedef __bf16 bf16x2_t __attribute__((ext_vector_type(2)));
typedef GAS unsigned gu32;
#define RLX_AGENT __ATOMIC_RELAXED, __HIP_MEMORY_SCOPE_AGENT
#define DI __device__ __forceinline__

constexpr int NB = 4, T = 8192, M = NB * T, D = 1024, NIN = 2828, NZ = 2816, FF = 3584, NE = 8;
constexpr int NC = 511;
constexpr int ZC_CB = 0, ZC_CC = 256, ZC_CU = 512, ZC_SSM = 768, ZC_SBQ = 1024, ZC_SBK = 1280, ZC_SBV = 1536, ZC_NQ = 1792, ZC_KV = 2048;
constexpr float RMS_EPS = 1e-6f;

DI unsigned f2bf(float f) { unsigned u = __builtin_bit_cast(unsigned, f); return (u + 0x7fffu + ((u >> 16) & 1u)) >> 16; }
DI unsigned pk2(float lo, float hi) { f32x2 v = {lo, hi}; bf16x2_t b = __builtin_convertvector(v, bf16x2_t); return __builtin_bit_cast(unsigned, b); }
DI float bf2f(unsigned b) { return __builtin_bit_cast(float, b << 16); }
DI float bflo(unsigned w) { return __builtin_bit_cast(float, w << 16); }
DI float bfhi(unsigned w) { return __builtin_bit_cast(float, w & 0xffff0000u); }
#define WR_DPP(v, ctrl) __builtin_bit_cast(float, __builtin_amdgcn_update_dpp(0, __builtin_bit_cast(int, (v)), (ctrl), 0xf, 0xf, true))
DI float wave_sum(float v) {
    v += WR_DPP(v, 0xB1); v += WR_DPP(v, 0x4E); v += WR_DPP(v, 0x141); v += WR_DPP(v, 0x140);
    const int b = __builtin_bit_cast(int, v);
    return (__builtin_bit_cast(float, __builtin_amdgcn_readlane(b, 0)) + __builtin_bit_cast(float, __builtin_amdgcn_readlane(b, 16))) + (__builtin_bit_cast(float, __builtin_amdgcn_readlane(b, 32)) + __builtin_bit_cast(float, __builtin_amdgcn_readlane(b, 48)));
}
DI float wave_max(float v) {
    v = fmaxf(v, WR_DPP(v, 0xB1)); v = fmaxf(v, WR_DPP(v, 0x4E)); v = fmaxf(v, WR_DPP(v, 0x141)); v = fmaxf(v, WR_DPP(v, 0x140));
    const int b = __builtin_bit_cast(int, v);
    return fmaxf(fmaxf(__builtin_bit_cast(float, __builtin_amdgcn_readlane(b, 0)), __builtin_bit_cast(float, __builtin_amdgcn_readlane(b, 16))), fmaxf(__builtin_bit_cast(float, __builtin_amdgcn_readlane(b, 32)), __builtin_bit_cast(float, __builtin_amdgcn_readlane(b, 48))));
}

namespace pg8 {
constexpr int BM = 256, BK = 64, HALF = 128, HTB = HALF * BK * 2, STAGE_BYTES = 8 * HTB, NXCD = 8, WGM = 8;
__host__ __device__ __forceinline__ int lds_byte(int r, int c) { const int st = (r >> 4) * 2 + (c >> 5), rr = r & 15, cc = c & 31, ob = rr * 64 + cc * 2; return st * 1024 + (ob ^ (((ob >> 9) & 1) << 5)); }
__host__ __device__ __forceinline__ void stage_rc(int b, int& R, int& C) { const int st = b / 1024, sb = b % 1024, swz = sb ^ (((sb >> 9) & 1) << 5); R = (st >> 1) * 16 + swz / 64; C = (st & 1) * 32 + (swz % 64) / 2; }
__host__ __device__ __forceinline__ int perm32(int rho) { const int n = rho >> 4, i = rho & 15; return 8 * (i >> 2) + 4 * n + (i & 3); }

struct Unit { int pm, pn, e, lt, pl, kt0, nkt, part; };
struct Gemm { const bf16* A; const bf16* Bt; int M, N, K; };

struct StaticOrder {
    int nM, nN, nwg, G, c, KT;
    __device__ void init(int M_, int N_, int K_, int G_, int c_) { nM = M_ / BM; nN = N_ / BM; nwg = nM * nN; G = G_; c = c_; KT = K_ / BK; }
    __device__ bool next(int i, Unit& u) const {
        const long L = (long)i * G + c; if (L >= nwg) return false;
        int wgid = (int)L; { const int q = nwg / NXCD, r = nwg % NXCD, xcd = wgid % NXCD, off = wgid / NXCD; wgid = (xcd < r ? xcd * (q + 1) : r * (q + 1) + (xcd - r) * q) + off; }
        const int nig = WGM * nN, gid = wgid / nig, fm = gid * WGM, gsz = (nM - fm) < WGM ? (nM - fm) : WGM;
        u.pm = fm + ((wgid % nig) % gsz); u.pn = (wgid % nig) / gsz; u.e = 0; u.lt = u.pm; u.pl = u.pn; u.kt0 = 0; u.nkt = KT; u.part = -1; return true;
    }
    __device__ __forceinline__ unsigned row_off(const Unit&, int) const { return 0u; }
};

struct MoeOrder {
    int nRT, nN, nwg, G, c, dense, K2;
    int KT, nfull, nsplit;
    const LAS int* tile_e; const LAS int* cnt; const int* list;
    __device__ bool next(int i, Unit& u) const {
        const long L = (long)i * G + c; int unit;
        if (L < nfull) { unit = (int)L; u.kt0 = 0; u.nkt = KT; u.part = -1; }
        else { const long s = L - nfull; if (s >= (long)(nwg - nfull) * nsplit) return false; unit = nfull + (int)(s / nsplit); const int sp = (int)(s % nsplit); u.nkt = KT / nsplit; u.kt0 = sp * u.nkt; u.part = (int)s; }
        decode(unit, u); return true;
    }
    __device__ void decode(int unit, Unit& u) const {
        int wgid = unit; { const int q = nwg / NXCD, r = nwg % NXCD, xcd = wgid % NXCD, off = wgid / NXCD; wgid = (xcd < r ? xcd * (q + 1) : r * (q + 1) + (xcd - r) * q) + off; }
        const int nig = WGM * nN, gid = wgid / nig, fm = gid * WGM, gsz = (nRT - fm) < WGM ? (nRT - fm) : WGM;
        u.pm = fm + ((wgid % nig) % gsz); u.pl = (wgid % nig) / gsz;
        const int te = dense ? (u.pm << 8) : __builtin_amdgcn_readfirstlane(tile_e[u.pm]); u.e = te & 255; u.lt = te >> 8; u.pn = u.e * nN + u.pl;
    }
    __device__ __forceinline__ unsigned row_off(const Unit& u, int r) const {
        const int idx = u.lt * 256 + r; int tok;
        if (dense) tok = idx; else tok = (idx < cnt[u.e]) ? list[u.e * 32768 + idx] : 0;
        return (unsigned)tok * (unsigned)K2;
    }
};

template <class Epi, class Sched, bool ALIGN_EPI, bool GATHER>
__device__ __forceinline__ void gemm_phase(LAS unsigned char* lds, const Gemm g, const Sched& S, const Epi& E) {
    int tid_l = threadIdx.x; asm volatile("" : "+v"(tid_l));
    const int tid = tid_l, wid = __builtin_amdgcn_readfirstlane(tid >> 6), lane = tid & 63, wr = wid >> 2, wc = wid & 3, fr = lane & 15, fq = lane >> 4;
    const int K = g.K;
    unsigned voffA[2], voffB[2]; int RA[2]; unsigned CA2[2];
#pragma unroll
    for (int i = 0; i < 2; ++i) { int R, C; stage_rc(tid * 16 + i * 8192, R, C); const int Rb = Epi::PERM ? ((R & ~31) + perm32(R & 31)) : R;
        voffA[i] = (unsigned)(R * K + C) * 2u; voffB[i] = (unsigned)(Rb * K + C) * 2u; RA[i] = R; CA2[i] = (unsigned)C * 2u; }
    const size_t kstep = (size_t)(BK * 2);
    const size_t hstep = (size_t)HALF * K * 2;
    const size_t tstep = 2 * hstep;
    const unsigned ldsw = (unsigned)wid * 1024u;
    const int aoff = lds_byte(wr * 64 + fr, fq * 8), boff = lds_byte(wc * 32 + fr, fq * 8);
#define PG8_SA(b, h) (((b) * 2 + (h)) * HTB)
#define PG8_SB(b, h) ((4 + (b) * 2 + (h)) * HTB)
#define PG8_STAGE(bufoff, gbase, voff) do { _Pragma("unroll") for (int _i = 0; _i < 2; ++_i) \
        __builtin_amdgcn_global_load_lds((const unsigned*)((const char*)(gbase) + (voff)[_i]), (LAS unsigned*)(lds + (bufoff) + ldsw + _i * 8192), 16, 0, 0); } while (0)
#define PG8_STAGE_A(b, h, gbase, vg) do { if constexpr (GATHER) { PG8_STAGE(PG8_SA(b, h), gbase, (vg)[h]); } else { PG8_STAGE(PG8_SA(b, h), (gbase) + (h) * hstep, voffA); } } while (0)
#define PG8_LDA(dst, b, h) do { _Pragma("unroll") for (int m = 0; m < 4; ++m) _Pragma("unroll") for (int k = 0; k < 2; ++k) dst[m][k] = *(const LAS bf16x8*)(lds + PG8_SA(b, h) + aoff + m * 2048 + k * 1024); } while (0)
#define PG8_LDB(dst, b, h) do { _Pragma("unroll") for (int n = 0; n < 2; ++n) _Pragma("unroll") for (int k = 0; k < 2; ++k) dst[n][k] = *(const LAS bf16x8*)(lds + PG8_SB(b, h) + boff + n * 2048 + k * 1024); } while (0)
#define PG8_MMA(ai, bj, At, Bt) do { __builtin_amdgcn_s_setprio(1); _Pragma("unroll") for (int m = 0; m < 4; ++m) _Pragma("unroll") for (int n = 0; n < 2; ++n) _Pragma("unroll") for (int k = 0; k < 2; ++k) \
        acc[ai][bj][m][n] = __builtin_amdgcn_mfma_f32_16x16x32_bf16(Bt[n][k], At[m][k], acc[ai][bj][m][n], 0, 0, 0); __builtin_amdgcn_s_setprio(0); } while (0)
#define PG8_WAIT_V(n) asm volatile("s_waitcnt vmcnt(" #n ")" ::: "memory")
#define PG8_WAIT_L(n) asm volatile("s_waitcnt lgkmcnt(" #n ")" ::: "memory")
#define PG8_BAR __builtin_amdgcn_s_barrier()
#define PG8_SCHED __builtin_amdgcn_sched_barrier(0)
    Unit cur, nxt; int ui = 0;
    if (!S.next(0, cur)) return;
    f32x4 acc[2][2][4][2];
#pragma unroll
    for (int a = 0; a < 2; ++a)
#pragma unroll
        for (int b = 0; b < 2; ++b)
#pragma unroll
            for (int m = 0; m < 4; ++m)
#pragma unroll
                for (int n = 0; n < 2; ++n) acc[a][b][m][n] = (f32x4){0.f, 0.f, 0.f, 0.f};
    bf16x8 At[4][2], B0[2][2], B1[2][2];
    unsigned vgc[2][2], vgn[2][2];
    const char* cA = (GATHER ? (const char*)g.A : (const char*)g.A + (size_t)cur.pm * tstep) + (size_t)cur.kt0 * kstep; const char* cB = (const char*)g.Bt + (size_t)cur.pn * tstep + (size_t)cur.kt0 * kstep;
    if constexpr (GATHER) {
#pragma unroll
        for (int h = 0; h < 2; ++h)
#pragma unroll
            for (int i = 0; i < 2; ++i) { vgc[h][i] = S.row_off(cur, h * HALF + RA[i]) + CA2[i]; vgn[h][i] = vgc[h][i]; }
    }
    PG8_STAGE(PG8_SB(0, 0), cB, voffB); PG8_STAGE(PG8_SB(0, 1), cB + hstep, voffB); PG8_STAGE_A(0, 0, cA, vgc); PG8_STAGE_A(0, 1, cA, vgc);
    if (wr == 1) PG8_BAR;
    PG8_WAIT_V(2); PG8_BAR;
    PG8_STAGE(PG8_SB(1, 0), cB + kstep, voffB); PG8_STAGE_A(1, 0, cA + kstep, vgc); PG8_STAGE(PG8_SB(1, 1), cB + hstep + kstep, voffB);
    PG8_WAIT_V(6); PG8_BAR;
    for (;;) {
        const bool has_next = S.next(ui + 1, nxt);
        const char* nA = has_next ? (GATHER ? (const char*)g.A : (const char*)g.A + (size_t)nxt.pm * tstep) + (size_t)nxt.kt0 * kstep : cA; const char* nB = has_next ? (const char*)g.Bt + (size_t)nxt.pn * tstep + (size_t)nxt.kt0 * kstep : cB;
        const int nt = cur.nkt;
        if constexpr (GATHER) {
            if (has_next) {
#pragma unroll
                for (int h = 0; h < 2; ++h)
#pragma unroll
                    for (int i = 0; i < 2; ++i) vgn[h][i] = S.row_off(nxt, h * HALF + RA[i]) + CA2[i];
            }
        }
        for (int t = 0; t < nt; t += 2) {
            const bool last = (t == nt - 2);
            const char* a1 = cA + (size_t)(t + 1) * kstep;
            const char* a2 = last ? nA : cA + (size_t)(t + 2) * kstep; const char* b2 = last ? nB : cB + (size_t)(t + 2) * kstep;
            const char* a3 = a2 + kstep; const char* b3 = b2 + kstep;
            unsigned vg2[2][2];
            if constexpr (GATHER) {
#pragma unroll
                for (int h = 0; h < 2; ++h)
#pragma unroll
                    for (int i = 0; i < 2; ++i) vg2[h][i] = last ? vgn[h][i] : vgc[h][i];
            }
            PG8_LDB(B0, 0, 0); PG8_LDB(B1, 0, 1); PG8_SCHED; PG8_LDA(At, 0, 0); PG8_STAGE_A(1, 1, a1, vgc);
            PG8_WAIT_V(8); PG8_WAIT_L(0); PG8_BAR; PG8_MMA(0, 0, At, B0); PG8_MMA(0, 1, At, B1); PG8_BAR; PG8_SCHED;
            PG8_LDA(At, 0, 1); PG8_STAGE(PG8_SB(0, 0), b2, voffB); PG8_STAGE(PG8_SB(0, 1), b2 + hstep, voffB); PG8_STAGE_A(0, 0, a2, vg2);
            PG8_WAIT_V(8); PG8_WAIT_L(0); PG8_BAR; PG8_MMA(1, 0, At, B0); PG8_MMA(1, 1, At, B1); PG8_BAR; PG8_SCHED;
            PG8_LDB(B0, 1, 0); PG8_LDB(B1, 1, 1); PG8_SCHED; PG8_LDA(At, 1, 0); PG8_STAGE_A(0, 1, a2, vg2);
            PG8_WAIT_V(8); PG8_WAIT_L(0); PG8_BAR; PG8_MMA(0, 0, At, B0); PG8_MMA(0, 1, At, B1); PG8_BAR; PG8_SCHED;
            PG8_LDA(At, 1, 1); PG8_STAGE(PG8_SB(1, 0), b3, voffB); PG8_STAGE(PG8_SB(1, 1), b3 + hstep, voffB); PG8_STAGE_A(1, 0, a3, vg2);
            PG8_WAIT_V(8); PG8_WAIT_L(0); PG8_BAR; PG8_MMA(1, 0, At, B0); PG8_MMA(1, 1, At, B1); PG8_BAR; PG8_SCHED;
        }
        if constexpr (ALIGN_EPI) { if (wr == 0) PG8_BAR; }
        E(acc, cur, wr, wc, fr, fq);
        if (!has_next) break;
#pragma unroll
        for (int a = 0; a < 2; ++a)
#pragma unroll
            for (int b = 0; b < 2; ++b)
#pragma unroll
                for (int m = 0; m < 4; ++m)
#pragma unroll
                    for (int n = 0; n < 2; ++n) acc[a][b][m][n] = (f32x4){0.f, 0.f, 0.f, 0.f};
        cur = nxt; cA = nA; cB = nB; ++ui;
        if constexpr (GATHER) {
#pragma unroll
            for (int h = 0; h < 2; ++h)
#pragma unroll
                for (int i = 0; i < 2; ++i) vgc[h][i] = vgn[h][i];
        }
        if constexpr (ALIGN_EPI) { if (wr == 1) PG8_BAR; }
    }
    PG8_WAIT_V(0);
    if constexpr (!ALIGN_EPI) { if (wr == 0) PG8_BAR; }
    PG8_BAR;
#undef PG8_SA
#undef PG8_SB
#undef PG8_STAGE
#undef PG8_STAGE_A
#undef PG8_LDA
#undef PG8_LDB
#undef PG8_MMA
#undef PG8_WAIT_V
#undef PG8_WAIT_L
#undef PG8_BAR
#undef PG8_SCHED
}
}
#define XB_TMO      128
#define XB_XCNT(j)  (256  + 64 * (j))
#define XB_XSUB(j)  (1280 + 64 * (j))
#define XB_XGEN(j)  (2304 + 64 * (j))
#define XB_TOP      3328
#define XB_TOPGEN   3392
#define XCD_BAR_WORDS 3456
#define XB_SPIN_CAP (1u << 18)

__device__ __forceinline__ unsigned xb_ld(unsigned* p)              { return __hip_atomic_load(p, __ATOMIC_RELAXED, __HIP_MEMORY_SCOPE_AGENT); }
__device__ __forceinline__ unsigned xb_add(unsigned* p, unsigned v) { return __hip_atomic_fetch_add(p, v, __ATOMIC_RELAXED, __HIP_MEMORY_SCOPE_AGENT); }
__device__ __forceinline__ unsigned xb_xcc_id() { return (unsigned)__builtin_amdgcn_s_getreg((3 << 11) | 20) & 0xFu; }
#define XB_SPIN(cond, bar) do { unsigned _sp = 0; while (cond) { __builtin_amdgcn_s_sleep(1); \
    if ((++_sp & 255u) == 0u) { if (xb_ld(&(bar)[XB_TMO])) break; if (_sp > XB_SPIN_CAP) { atomicAdd(&(bar)[XB_TMO], 1u); break; } } } } while (0)

struct XcdBarrier {
    unsigned* bar; unsigned x;
    volatile LAS unsigned* st;
};

__device__ __forceinline__ XcdBarrier xcd_barrier_post(unsigned* bar, volatile LAS unsigned* st) {
    XcdBarrier b; b.bar = bar; b.x = xb_xcc_id(); b.st = st;
    if (threadIdx.x == 0) (void)xb_add(&bar[XB_XCNT(b.x)], 1u);
    return b;
}
__device__ __forceinline__ void xcd_barrier_complete(unsigned* bar, unsigned x, unsigned& nloc, unsigned& nx) {
    const unsigned G = gridDim.x * gridDim.y * gridDim.z;
    unsigned sum, cnt, mine, sp = 0u;
    for (;;) {
        sum = 0u; cnt = 0u; mine = 0u;
#pragma unroll
        for (unsigned j = 0; j < 16; ++j) { const unsigned c = xb_ld(&bar[XB_XCNT(j)]); sum += c; cnt += (c > 0u) ? 1u : 0u; mine = (j == x) ? c : mine; }
        if (sum == G) break;
        __builtin_amdgcn_s_sleep(1);
        if ((++sp & 255u) == 0u) { if (xb_ld(&bar[XB_TMO])) break; if (sp > XB_SPIN_CAP) { atomicAdd(&bar[XB_TMO], 1u); break; } }
    }
    nloc = mine > 0u ? mine : 1u; nx = cnt > 0u ? cnt : 1u;
}

__device__ __forceinline__ void xcd_barrier(const XcdBarrier& b) {
    asm volatile("s_waitcnt vmcnt(0)" ::: "memory");
    __syncthreads();
    if (threadIdx.x == 0) {
        unsigned* bar = b.bar;
        __builtin_amdgcn_s_waitcnt(0);
        unsigned nloc = b.st[0], nx = b.st[1];
        if (nloc == 0u) { xcd_barrier_complete(bar, b.x, nloc, nx); b.st[0] = nloc; b.st[1] = nx; }
        const unsigned old = xb_add(&bar[XB_XSUB(b.x)], 1u);
        const unsigned gen = old / nloc;
        if (old + 1u == (gen + 1u) * nloc) {
            __builtin_amdgcn_fence(__ATOMIC_RELEASE, "agent");
            asm volatile("s_waitcnt vmcnt(0)" ::: "memory");
            const unsigned og = xb_add(&bar[XB_TOP], 1u);
            const unsigned tg = og / nx;
            if (og + 1u == (tg + 1u) * nx) xb_add(&bar[XB_TOPGEN], 1u);
            else XB_SPIN(xb_ld(&bar[XB_TOPGEN]) == tg, bar);
            __builtin_amdgcn_fence(__ATOMIC_ACQUIRE, "agent");
            xb_add(&bar[XB_XGEN(b.x)], 1u);
            asm volatile("s_waitcnt vmcnt(0)" ::: "memory");
        } else {
            XB_SPIN(xb_ld(&bar[XB_XGEN(b.x)]) == gen, bar);
            __builtin_amdgcn_fence(__ATOMIC_ACQUIRE, "agent");
            asm volatile("s_waitcnt vmcnt(0)" ::: "memory");
        }
    }
    __syncthreads();
}

constexpr size_t MiB = 1u << 20;
constexpr size_t WS_CTL = 0, CTL_ZERO_BYTES = 1 * MiB;
constexpr size_t WS_MOD = 1 * MiB;
constexpr size_t WS_CBIAS = WS_MOD + 256 * 1024;
constexpr size_t WS_GL = 2 * MiB;
constexpr size_t WS_RTW = 4 * MiB;
constexpr size_t WS_LIST = 5 * MiB;
constexpr size_t WS_S5E = 7 * MiB;
constexpr size_t WS_S5C = 12 * MiB;
constexpr size_t WS_KC = 11 * MiB;
constexpr size_t WS_VCT = WS_KC + 512 * 1024;
constexpr size_t WS_WIN = 16 * MiB;
constexpr size_t WS_WOUT = 27 * MiB;
constexpr size_t WS_WGUD = 31 * MiB;
constexpr size_t WS_WDD = 45 * MiB;
constexpr size_t WS_WGUM = 52 * MiB;
constexpr size_t WS_WDM = 164 * MiB;
constexpr size_t WS_CW1 = 220 * MiB;
constexpr size_t WS_CW2 = 224 * MiB;
constexpr size_t WS_WGLU = WS_CW2 + 512 * 1024;
constexpr size_t WS_H16 = 226 * MiB;
constexpr size_t OB_ROPE = 64 * MiB;
constexpr size_t OB_YL = 72 * MiB;
constexpr size_t OB_WIN = 104 * MiB;
constexpr int NZP = 3072;
constexpr size_t OB_A = 0, OB_KFSB = 0 * MiB, OB_VFSB = 16 * MiB, OB_KFSLC = 32 * MiB, OB_VFSLC = 40 * MiB, OB_KFWIN = 48 * MiB, OB_VFWIN = 56 * MiB;
constexpr size_t WS_Z = 290 * MiB;
constexpr size_t WS_Y = 466 * MiB;
constexpr size_t WS_HID = 290 * MiB;
constexpr size_t WS_PART = 530 * MiB;
constexpr size_t WS_END = 586 * MiB;
static_assert(WS_HID + (size_t)34816 * FF * 2 <= WS_PART && WS_PART + (size_t)224 * 65536 * 4 <= WS_END && WS_Z + (size_t)M * NZ * 2 <= WS_Y && WS_Y + (size_t)M * D * 2 <= WS_END, "ws map");
static_assert(WS_WDM + (size_t)8 * 1024 * FF * 2 <= WS_CW1 && WS_WGUM + (size_t)8 * 7168 * 1024 * 2 <= WS_WDM && WS_WIN + (size_t)2 * NZ * D * 2 <= WS_WOUT, "ws map 2");
constexpr int CW_BAR = 4096, CW_CNT = 8192  , CW_Q = 12288  , CW_S5F = 13312  ;

constexpr int RING_BYTES = 131072, NSA_STG_OFF = RING_BYTES  , LDSCTL_OFF = RING_BYTES + 20480, LDS_BYTES = LDSCTL_OFF + 4096;
constexpr int LC_MISC = 0, LC_BAR = 8, LC_CNT = 16, LC_TILE = 32, LC_BASE = 200  , LC_LCNT = 216  , LC_UNI = 232  , LC_BLIST = 256  , LC_ITEMS = 384  ;

#ifndef CMP_WGS
#define CMP_WGS 64
#endif
#ifndef NORM_PF
#define NORM_PF 4
#endif
#define LDS_BARRIER() do { asm volatile("s_waitcnt lgkmcnt(0)" ::: "memory"); __builtin_amdgcn_s_barrier(); asm volatile("" ::: "memory"); } while (0)
#define LDS_WAIT() asm volatile("s_waitcnt lgkmcnt(0)" ::: "memory")
#define VM_WAIT() asm volatile("s_waitcnt vmcnt(0)" ::: "memory")
constexpr float LOG2E = 1.4426950408889634f, LN2 = 0.6931471805599453f;

DI float fexp2(float x) { return __builtin_amdgcn_exp2f(x); }
DI float fexp(float x) { return __builtin_amdgcn_exp2f(x * LOG2E); }
DI float sigmoidf_(float x) { return __builtin_amdgcn_rcpf(1.f + fexp(-x)); }
DI float siluf_(float x) { return x * sigmoidf_(x); }
DI float gelu_tanh(float x) { const float u = 0.7978845608028654f * (x + 0.044715f * x * x * x); const float th = 1.f - 2.f * __builtin_amdgcn_rcpf(fexp(2.f * u) + 1.f); return 0.5f * x * (1.f + th); }
typedef _Float16 f16; typedef _Float16 f16x2_t __attribute__((ext_vector_type(2)));
DI unsigned pkh(float lo, float hi) { f16x2_t v = {(f16)__builtin_amdgcn_fmed3f(lo, -65504.f, 65504.f), (f16)__builtin_amdgcn_fmed3f(hi, -65504.f, 65504.f)}; return __builtin_bit_cast(unsigned, v); }
DI f32x4 h4(unsigned a, unsigned b) { const f16x2_t x = __builtin_bit_cast(f16x2_t, a), y = __builtin_bit_cast(f16x2_t, b); return (f32x4){(float)x[0], (float)x[1], (float)y[0], (float)y[1]}; }
DI int crow(int r, int hi) { return (r & 3) + 8 * (r >> 2) + 4 * hi; }

struct EpiZ {
    static constexpr bool PERM = true;
    bf16* O; float* GL;
    DI void operator()(const f32x4 (&acc)[2][2][4][2], const pg8::Unit& u, int wr, int wc, int fr, int fq) const {
        const int row0 = u.pm * 256 + wr * 64 + fr, col0 = u.pn * 256 + wc * 32 + 8 * fq;
        if (u.pn == 11) {
            if (wc == 0 && fq < 2) {
#pragma unroll
                for (int ai = 0; ai < 2; ++ai)
#pragma unroll
                    for (int m = 0; m < 4; ++m) { float* gp = GL + (size_t)(row0 + ai * 128 + m * 16) * 12 + 8 * fq;
                        *(f32x4*)gp = acc[ai][0][m][0]; if (fq == 0) *(f32x4*)(gp + 4) = acc[ai][0][m][1]; } }
            return; }
#pragma unroll
        for (int ai = 0; ai < 2; ++ai)
#pragma unroll
            for (int m = 0; m < 4; ++m) { bf16* rowp = O + (size_t)(row0 + ai * 128 + m * 16) * NZ + col0;
#pragma unroll
                for (int bj = 0; bj < 2; ++bj) { const f32x4 v0 = acc[ai][bj][m][0], v1 = acc[ai][bj][m][1];
                    u32x4 w; w.x = pk2(v0[0], v0[1]); w.y = pk2(v0[2], v0[3]); w.z = pk2(v1[0], v1[1]); w.w = pk2(v1[2], v1[3]);
                    *(u32x4*)(rowp + bj * 128) = w; } }
    }
};
struct EpiRes {
    static constexpr bool PERM = true;
    const float* x; f16* h; const float* modl;
    DI void operator()(const f32x4 (&acc)[2][2][4][2], const pg8::Unit& u, int wr, int wc, int fr, int fq) const {
        const int row0 = u.pm * 256 + wr * 64 + fr, col0 = u.pn * 256 + wc * 32 + 8 * fq;
        const int b = (u.pm * 256) / T; const float* gp = modl + b * 6144 + 2048 + col0;
        f32x4 gv[2][2];
#pragma unroll
        for (int bj = 0; bj < 2; ++bj)
#pragma unroll
            for (int n = 0; n < 2; ++n) gv[bj][n] = *(const f32x4*)(gp + bj * 128 + 4 * n);
#pragma unroll
        for (int hq = 0; hq < 4; ++hq) {
            const int ai = hq >> 1, m0 = (hq & 1) * 2;
            if (x) {
                f32x4 rv[2][2][2];
#pragma unroll
                for (int mm = 0; mm < 2; ++mm)
#pragma unroll
                    for (int bj = 0; bj < 2; ++bj) { const float* xp = x + (size_t)(row0 + ai * 128 + (m0 + mm) * 16) * D + col0 + bj * 128; rv[mm][bj][0] = *(const f32x4*)xp; rv[mm][bj][1] = *(const f32x4*)(xp + 4); }
#pragma unroll
                for (int mm = 0; mm < 2; ++mm)
#pragma unroll
                    for (int bj = 0; bj < 2; ++bj) { const int m = m0 + mm; const f32x4 o0 = rv[mm][bj][0] + gv[bj][0] * acc[ai][bj][m][0], o1 = rv[mm][bj][1] + gv[bj][1] * acc[ai][bj][m][1];
                        u32x4 w; w.x = pkh(o0.x, o0.y); w.y = pkh(o0.z, o0.w); w.z = pkh(o1.x, o1.y); w.w = pkh(o1.z, o1.w);
                        *(u32x4*)(h + (size_t)(row0 + ai * 128 + m * 16) * D + col0 + bj * 128) = w; }
            } else {
                u32x4 tv[2][2];
#pragma unroll
                for (int mm = 0; mm < 2; ++mm)
#pragma unroll
                    for (int bj = 0; bj < 2; ++bj) tv[mm][bj] = *(const u32x4*)(h + (size_t)(row0 + ai * 128 + (m0 + mm) * 16) * D + col0 + bj * 128);
#pragma unroll
                for (int mm = 0; mm < 2; ++mm)
#pragma unroll
                    for (int bj = 0; bj < 2; ++bj) { const int m = m0 + mm; const u32x4 t = tv[mm][bj]; const f32x4 o0 = h4(t.x, t.y) + gv[bj][0] * acc[ai][bj][m][0], o1 = h4(t.z, t.w) + gv[bj][1] * acc[ai][bj][m][1];
                        u32x4 w; w.x = pkh(o0.x, o0.y); w.y = pkh(o0.z, o0.w); w.z = pkh(o1.x, o1.y); w.w = pkh(o1.z, o1.w);
                        *(u32x4*)(h + (size_t)(row0 + ai * 128 + m * 16) * D + col0 + bj * 128) = w; }
            }
        }
    }
};
struct EpiSwiglu {
    static constexpr bool PERM = true;
    bf16* H;
    DI void operator()(const f32x4 (&acc)[2][2][4][2], const pg8::Unit& u, int wr, int wc, int fr, int fq) const {
        const int row0 = u.pm * 256 + wr * 64 + fr, col0 = u.pl * 128 + wc * 32 + 8 * fq;
#pragma unroll
        for (int ai = 0; ai < 2; ++ai)
#pragma unroll
            for (int m = 0; m < 4; ++m) { bf16* rowp = H + (size_t)(row0 + ai * 128 + m * 16) * FF + col0;
                float o[8];
#pragma unroll
                for (int n = 0; n < 2; ++n)
#pragma unroll
                    for (int j = 0; j < 4; ++j) o[4 * n + j] = siluf_(acc[ai][0][m][n][j]) * acc[ai][1][m][n][j];
                u32x4 w; w.x = pk2(o[0], o[1]); w.y = pk2(o[2], o[3]); w.z = pk2(o[4], o[5]); w.w = pk2(o[6], o[7]);
                *(u32x4*)rowp = w; }
    }
};
struct EpiDown {
    static constexpr bool PERM = true;
    f16* h; float* outf; const float* modl; const int* list; const float* rtw; const LAS int* cnt; int dense, kpass, fin; float* part;
    DI void operator()(const f32x4 (&acc)[2][2][4][2], const pg8::Unit& u, int wr, int wc, int fr, int fq) const {
        if (u.part >= 0) {
            float* pb = part + (size_t)u.part * 65536 + (wr * 64 + fr) * 256 + wc * 32 + 8 * fq;
#pragma unroll
            for (int ai = 0; ai < 2; ++ai)
#pragma unroll
                for (int m = 0; m < 4; ++m)
#pragma unroll
                    for (int bj = 0; bj < 2; ++bj)
#pragma unroll
                        for (int n = 0; n < 2; ++n) *(f32x4*)(pb + (ai * 128 + m * 16) * 256 + bj * 128 + 4 * n) = acc[ai][bj][m][n];
            return; }
        const int r0 = wr * 64 + fr, col0 = u.pl * 256 + wc * 32 + 8 * fq;
        const int ce = dense ? 0 : cnt[u.e];
        int tokv[8]; float wv[8];
#pragma unroll
        for (int q = 0; q < 8; ++q) { const int idx = u.lt * 256 + r0 + (q >> 2) * 128 + (q & 3) * 16;
            tokv[q] = dense ? idx : ((idx < ce) ? list[u.e * 32768 + idx] : -1); }
#pragma unroll
        for (int q = 0; q < 8; ++q) wv[q] = dense ? 1.f : ((tokv[q] >= 0) ? rtw[tokv[q] * 2 + kpass] : 0.f);
#pragma unroll
        for (int hq = 0; hq < 4; ++hq) {
            u32x4 tv[2][2]; f32x4 g0v[2][2], g1v[2][2];
#pragma unroll
            for (int mm = 0; mm < 2; ++mm) { const int tok = tokv[hq * 2 + mm]; const int tk = tok >= 0 ? tok : 0; const float* gp = modl + (tk >> 13) * 6144 + 5120 + col0; const f16* hp = h + (size_t)tk * D + col0;
#pragma unroll
                for (int bj = 0; bj < 2; ++bj) { tv[mm][bj] = *(const u32x4*)(hp + bj * 128); g0v[mm][bj] = *(const f32x4*)(gp + bj * 128); g1v[mm][bj] = *(const f32x4*)(gp + bj * 128 + 4); } }
#pragma unroll
            for (int mm = 0; mm < 2; ++mm) { const int q = hq * 2 + mm, ai = q >> 2, m = q & 3; const int tok = tokv[q]; const float w = wv[q];
                if (tok >= 0) { f16* hp = h + (size_t)tok * D + col0; float* op = outf + (size_t)tok * D + col0;
#pragma unroll
                    for (int bj = 0; bj < 2; ++bj) { const u32x4 t = tv[mm][bj];
                        const f32x4 o0 = h4(t.x, t.y) + (g0v[mm][bj] * w) * acc[ai][bj][m][0], o1 = h4(t.z, t.w) + (g1v[mm][bj] * w) * acc[ai][bj][m][1];
                        if (fin) { *(f32x4*)(op + bj * 128) = o0; *(f32x4*)(op + bj * 128 + 4) = o1; }
                        else { u32x4 wv2; wv2.x = pkh(o0.x, o0.y); wv2.y = pkh(o0.z, o0.w); wv2.z = pkh(o1.x, o1.y); wv2.w = pkh(o1.z, o1.w); *(u32x4*)(hp + bj * 128) = wv2; } } } }
        }
    }
};

struct Args { const void* in[34]; float* out; unsigned char* ws; };
typedef const __attribute__((address_space(4))) Args& KArgsR;
enum { I_X = 0, I_C, I_POS, I_ADAW, I_ADAB, I_NMG, I_NFG, I_WIN, I_WOUT, I_CONVW, I_LRE, I_LIM, I_BRE, I_BIM, I_CRE, I_CIM, I_SD, I_LDT, I_WGLU, I_QNG, I_KNG, I_PK, I_PV, I_KW1, I_KW2, I_VW1, I_VW2,
       I_FG, I_FU, I_FD, I_MR, I_MG, I_MU, I_MD };

DI void tr_item(const float* W, int ldw, int K, bf16* WT, int dst_row0, int k0, int n0, LAS float* scr, int lane, int tiled = 0) {
    const int kq = lane >> 4, n4 = (lane & 15) * 4;
    f32x4 v[16];
#pragma unroll
    for (int i = 0; i < 16; ++i) v[i] = *(const f32x4*)(W + (size_t)(k0 + 4 * i + kq) * ldw + n0 + n4);
#pragma unroll
    for (int i = 0; i < 16; ++i) { LAS float* d = scr + (4 * i + kq) * 65 + n4; d[0] = v[i].x; d[1] = v[i].y; d[2] = v[i].z; d[3] = v[i].w; }
    LDS_WAIT(); asm volatile("" ::: "memory");
    const int c = lane & 7;
#pragma unroll
    for (int j = 0; j < 8; ++j) { const int n = (lane >> 3) + 8 * j; const LAS float* s = scr + (8 * c) * 65 + n;
        u32x4 o; o.x = pk2(s[0 * 65], s[1 * 65]); o.y = pk2(s[2 * 65], s[3 * 65]); o.z = pk2(s[4 * 65], s[5 * 65]); o.w = pk2(s[6 * 65], s[7 * 65]);
        const int nabs = dst_row0 + n, kk = k0 + 8 * c;
        bf16* dst = tiled ? WT + ((size_t)((nabs >> 4) * (K >> 5) + (kk >> 5)) * 64 + (nabs & 15) + 16 * ((kk >> 3) & 3)) * 8 : WT + (size_t)nabs * K + kk;
        *(u32x4*)dst = o; }
    LDS_WAIT(); asm volatile("" ::: "memory");
}
DI int gu_row(int n0, int up) { return (n0 >> 7) * 256 + (n0 & 127) + (up ? 128 : 0); }
constexpr int IT_WIN = 16 * 45, IT_WOUT = 16 * 16, IT_GU = 16 * 56, IT_DN = 56 * 16, IT_C1 = 32 * 4, IT_C2 = 4 * 1, IT_GLU = 4 * 4;
constexpr int IT_TOTAL = 2 * (IT_WIN + IT_WOUT) + (2 * IT_GU + IT_DN) * 9 + 4 * IT_C1 + 4 * IT_C2 + 2 * IT_GLU;
DI void conv_item(KArgsR a, int r, LAS float* scr, int lane) {
    unsigned char* ws = a.ws;
    const float* W; int ldw, K, row0, kb, nb, tiled = 0, n0c = -1; bf16* WT;
    const int per_l = IT_WIN + IT_WOUT;
    if (r < 2 * per_l) { const int l = r / per_l; r -= l * per_l;
        if (r < IT_WIN) { kb = r % 16; nb = r / 16; W = (const float*)a.in[I_WIN] + (size_t)l * D * NIN; ldw = NIN; K = D; WT = (bf16*)((unsigned char*)a.out + OB_WIN) + (size_t)l * NZP * D; row0 = 64 * nb;
            if (nb == 44) { row0 = NIN - 64; n0c = NIN - 64; } }
        else { r -= IT_WIN; kb = r % 16; nb = r / 16; W = (const float*)a.in[I_WOUT] + (size_t)l * D * D; ldw = D; K = D; WT = (bf16*)(ws + WS_WOUT) + (size_t)l * D * D; row0 = 64 * nb; } }
    else { r -= 2 * per_l;
        constexpr int PER_E = 2 * IT_GU + IT_DN;
        if (r < 9 * PER_E) {
            const int e = r / PER_E; r -= e * PER_E; const int ex = e > 0 ? e - 1 : 0;
            if (r < 2 * IT_GU) { const int up = r >= IT_GU; r -= up * IT_GU; kb = r % 16; nb = r / 16; ldw = FF; K = D; row0 = gu_row(64 * nb, up);
                W = e == 0 ? (const float*)a.in[up ? I_FU : I_FG] : (const float*)a.in[up ? I_MU : I_MG] + (size_t)ex * D * FF;
                WT = e == 0 ? (bf16*)(ws + WS_WGUD) : (bf16*)(ws + WS_WGUM) + (size_t)ex * 7168 * D; }
            else { r -= 2 * IT_GU; kb = r % 56; nb = r / 56; ldw = D; K = FF; row0 = 64 * nb;
                W = e == 0 ? (const float*)a.in[I_FD] : (const float*)a.in[I_MD] + (size_t)ex * FF * D;
                WT = e == 0 ? (bf16*)(ws + WS_WDD) : (bf16*)(ws + WS_WDM) + (size_t)ex * D * FF; } }
        else { r -= 9 * PER_E;
            if (r < 4 * IT_C1) { const int m = r / IT_C1, rr = r % IT_C1, l = m >> 1, kv = m & 1; kb = rr / 4; nb = rr % 4; ldw = 256; K = 2048; row0 = 64 * nb; tiled = 1;
                W = (const float*)a.in[kv ? I_VW1 : I_KW1] + (size_t)l * 2048 * 256; WT = (bf16*)(ws + WS_CW1) + (size_t)m * 256 * 2048; }
            else { r -= 4 * IT_C1;
                if (r < 4 * IT_C2) { const int m = r / IT_C2, rr = r % IT_C2, l = m >> 1, kv = m & 1; kb = rr; nb = 0; ldw = 64; K = 256; row0 = 0;
                    W = (const float*)a.in[kv ? I_VW2 : I_KW2] + (size_t)l * 256 * 64; WT = (bf16*)(ws + WS_CW2) + (size_t)m * 64 * 256; }
                else { r -= 4 * IT_C2; const int l = r / IT_GLU, rr = r % IT_GLU; kb = rr / 4; nb = rr % 4; ldw = 256; K = 256; row0 = 64 * nb;
                    W = (const float*)a.in[I_WGLU] + (size_t)l * 256 * 256; WT = (bf16*)(ws + WS_WGLU) + (size_t)l * 256 * 256; } } } }
    tr_item(W, ldw, K, WT, row0, 64 * kb, n0c >= 0 ? n0c : 64 * nb, scr, lane, tiled);
}

DI void prologue(KArgsR a, LAS unsigned char* lds, int tid, int lane, int wave, int G) {
    LAS float* condL = (LAS float*)(lds + 98304);
    for (int i = tid; i < 4096; i += 512) condL[i] = siluf_(((const float*)a.in[I_C])[i]);
    __syncthreads();
    const int gw = blockIdx.x * 8 + wave, NGW = G * 8;
    LAS float* red = (LAS float*)(lds + 98304 + 16384);
    for (int mt = blockIdx.x; mt < 192; mt += G) {
        const int l = mt / 96, n = (mt % 96) * 64 + lane;
        const float* wp = (const float*)a.in[I_ADAW] + (size_t)l * D * 6144 + n;
        float acc[4] = {0.f, 0.f, 0.f, 0.f};
#pragma unroll 1
        for (int kk = 0; kk < 128; kk += 32) { const int k0 = 128 * wave + kk;
            float w[32];
#pragma unroll
            for (int i = 0; i < 32; ++i) w[i] = wp[(size_t)(k0 + i) * 6144];
#pragma unroll
            for (int i = 0; i < 32; ++i)
#pragma unroll
                for (int b = 0; b < 4; ++b) acc[b] += condL[b * 1024 + k0 + i] * w[i];
        }
#pragma unroll
        for (int b = 0; b < 4; ++b) red[(wave * 4 + b) * 64 + lane] = acc[b];
        __syncthreads();
        if (wave < 4) { float s = ((const float*)a.in[I_ADAB])[l * 6144 + n];
#pragma unroll
            for (int w8 = 0; w8 < 8; ++w8) s += red[(w8 * 4 + wave) * 64 + lane];
            ((float*)(a.ws + WS_MOD))[(l * 4 + wave) * 6144 + n] = s; }
        __syncthreads();
    }
    for (int ct = (int)blockIdx.x - 192; ct >= 0 && ct < 16; ct += G) {
        const int l = ct >> 3, kv = (ct >> 2) & 1, n = (ct & 3) * 64 + lane;
        const float* pos = (const float*)a.in[kv ? I_PV : I_PK] + l * 2048; const float* w1 = (const float*)a.in[kv ? I_VW1 : I_KW1] + (size_t)l * 2048 * 256 + n;
        float acc = 0.f;
#pragma unroll 1
        for (int kk = 0; kk < 256; kk += 32) { const int k0 = 256 * wave + kk;
            float w[32];
#pragma unroll
            for (int i = 0; i < 32; ++i) w[i] = w1[(size_t)(k0 + i) * 256];
#pragma unroll
            for (int i = 0; i < 32; ++i) acc += pos[k0 + i] * w[i];
        }
        red[wave * 64 + lane] = acc;
        __syncthreads();
        if (wave == 0) { float s = 0.f;
#pragma unroll
            for (int w8 = 0; w8 < 8; ++w8) s += red[w8 * 64 + lane];
            ((float*)(a.ws + WS_CBIAS))[(l * 2 + kv) * 256 + n] = s; }
        __syncthreads();
    }
    { f32x2* ropet = (f32x2*)((unsigned char*)a.out + OB_ROPE); const int* posp = (const int*)a.in[I_POS];
      const int i = lane & 31; const float inv = exp2f(-(float)i * (13.287712379549449f / 32.f));
      int posv[8];
#pragma unroll
      for (int q = 0; q < 8; ++q) { const int r2 = gw + q * NGW; posv[q] = (r2 < M / 2) ? posp[2 * r2 + (lane >> 5)] : 0; }
#pragma unroll 1
      for (int q = 0; q < 8; ++q) { const int r2 = gw + q * NGW; if (r2 >= M / 2) break; const int row = 2 * r2 + (lane >> 5);
          int pq = posv[0];
#pragma unroll
          for (int qq = 1; qq < 8; ++qq) pq = (q == qq) ? posv[qq] : pq;
          float sn, cs; sincosf((float)pq * inv, &sn, &cs); ropet[(size_t)row * 32 + i] = (f32x2){cs, sn}; }
      for (int r2 = gw + 8 * NGW; r2 < M / 2; r2 += NGW) { const int row = 2 * r2 + (lane >> 5); float sn, cs; sincosf((float)posp[row] * inv, &sn, &cs); ropet[(size_t)row * 32 + i] = (f32x2){cs, sn}; } }
    __syncthreads();
    LAS float* scr = (LAS float*)(lds + wave * 16640);
    for (int it = gw; it < IT_TOTAL; it += NGW) conv_item(a, it, scr, lane);
}

template <bool F16> struct NormRaw { typedef u32x4 T; }; template <> struct NormRaw<true> { typedef u32x2 T; };
template <int NS, bool F16, int RPW = 16>
DI void norm_phase(KArgsR a, const void* hin, const float* gain, const float* modl, int sh_off, const float* Wsm, int ldws, LAS unsigned char* lds, int tid, int lane, int wave, int G, int rowbeg = 0, int nrows = M, size_t aoff = OB_A, bool logits = true) {
    static_assert(NS != 8 || RPW == 16, "the routing path keeps one row per lane 0..15");
    LAS float* Ws = (LAS float*)lds;
    LAS int* lc = (LAS int*)(lds + LDSCTL_OFF);
    gu32* ctl = (gu32*)(a.ws + WS_CTL);
    bf16* aout = (bf16*)((unsigned char*)a.out + aoff);
    if constexpr (NS > 0) if (logits) {
        for (int i = tid; i < NS * 1024; i += 512) { const int k = i / NS, n = i % NS; Ws[n * 1024 + k] = Wsm[(size_t)k * ldws + n]; }
        __syncthreads();
    }
    for (int base = blockIdx.x * 8; base < nrows / RPW; base += G * 8) {
        const int rb = base + wave, row0 = rowbeg + rb * RPW, b = row0 / T;
        f32x4 Av[4], Bv[4];
#pragma unroll
        for (int j = 0; j < 4; ++j) { const int col = 4 * lane + 256 * j;
            const f32x4 g4 = *(const f32x4*)(gain + col), sc = *(const f32x4*)(modl + b * 6144 + sh_off + 1024 + col);
            Av[j] = g4 * (sc + 1.0f); Bv[j] = *(const f32x4*)(modl + b * 6144 + sh_off + col); }
        int e0k = 0, e1k = 0, p0k = 0, p1k = 0;
        if constexpr (NS == 8) { if (tid < 16) lc[LC_LCNT + tid] = 0; __syncthreads(); }
        typedef typename NormRaw<F16>::T RawT;
        constexpr int PF = NORM_PF; static_assert(RPW % PF == 0, "ring depth");
        RawT vn[PF][4];
#pragma unroll
        for (int k = 0; k < PF; ++k) { const RawT* xr0 = (const RawT*)hin + (size_t)(row0 + k) * (D / 4) + lane;
#pragma unroll
            for (int j = 0; j < 4; ++j) vn[k][j] = xr0[64 * j]; }
#pragma unroll 1
        for (int rr0 = 0; rr0 < RPW; rr0 += PF) {
#pragma unroll
          for (int k = 0; k < PF; ++k) {
            const int rr = rr0 + k, row = row0 + rr;
            f32x4 v[4]; float ss = 0.f;
#pragma unroll
            for (int j = 0; j < 4; ++j) { if constexpr (F16) v[j] = h4(vn[k][j].x, vn[k][j].y); else v[j] = __builtin_bit_cast(f32x4, vn[k][j]);
                ss += (v[j].x * v[j].x + v[j].y * v[j].y) + (v[j].z * v[j].z + v[j].w * v[j].w); }
            if (rr + PF < RPW) { const RawT* xn = (const RawT*)hin + (size_t)(row + PF) * (D / 4) + lane;
#pragma unroll
                for (int j = 0; j < 4; ++j) vn[k][j] = xn[64 * j]; }
            const float rstd = rsqrtf(wave_sum(ss) * (1.f / D) + RMS_EPS);
            unsigned long long* o8 = (unsigned long long*)(aout + (size_t)row * D) + lane;
#pragma unroll
            for (int j = 0; j < 4; ++j) { v[j] = (v[j] * rstd) * Av[j] + Bv[j];
                o8[64 * j] = (unsigned long long)pk2(v[j].x, v[j].y) | ((unsigned long long)pk2(v[j].z, v[j].w) << 32); }
            if constexpr (NS > 0) if (logits) {
                constexpr int NV = (NS > 8) ? 16 : 8;
                float pa[NV];
#pragma unroll
                for (int n = 0; n < NV; ++n) { float acc = 0.f;
                    if (n < NS) {
#pragma unroll
                        for (int j = 0; j < 4; ++j) { const f32x4 w = *(const LAS f32x4*)(Ws + n * 1024 + 4 * lane + 256 * j); acc += (v[j].x * w.x + v[j].y * w.y) + (v[j].z * w.z + v[j].w * w.w); } }
                    pa[n] = acc; if ((n & 3) == 3) __builtin_amdgcn_sched_barrier(0); }
#define NP_BFLY(cnt, off) { const bool up = (lane & (off)) != 0; _Pragma("unroll") for (int i = 0; i < (cnt); ++i) { const float keep = up ? pa[i + (cnt)] : pa[i], send = up ? pa[i] : pa[i + (cnt)]; pa[i] = keep + __shfl_xor(send, (off)); } }
                float tot;
                if constexpr (NV == 16) { NP_BFLY(8, 32) NP_BFLY(4, 16) NP_BFLY(2, 8) NP_BFLY(1, 4) tot = pa[0]; tot += __shfl_xor(tot, 2); tot += __shfl_xor(tot, 1); }
                else { NP_BFLY(4, 32) NP_BFLY(2, 16) NP_BFLY(1, 8) tot = pa[0]; tot += __shfl_xor(tot, 4); tot += __shfl_xor(tot, 2); tot += __shfl_xor(tot, 1); }
#undef NP_BFLY
                const float o = __shfl(tot, (lane * (64 / NV)) & 63);
                if constexpr (NS == 12) {
                    if (lane < 12) ((float*)(a.ws + WS_GL))[(size_t)row * 12 + lane] = o;
                } else {
                    const float c0 = (lane < 8) ? o : -3.0e38f; const float v0 = wave_max(c0);
                    const int i0 = __builtin_ctzll(__ballot(c0 == v0));
                    const float c1v = (lane < 8 && lane != i0) ? o : -3.0e38f; const float v1 = wave_max(c1v);
                    const int i1 = __builtin_ctzll(__ballot(c1v == v1 && lane < 8 && lane != i0));
                    const float w0 = __builtin_amdgcn_rcpf(1.f + fexp(v1 - v0));
                    if (lane == 0) { ((float*)(a.ws + WS_RTW))[row * 2] = w0; ((float*)(a.ws + WS_RTW))[row * 2 + 1] = 1.f - w0; }
                    if (lane == rr) { const int lp0 = __hip_atomic_fetch_add(&lc[LC_LCNT + i0], 1, __ATOMIC_RELAXED, __HIP_MEMORY_SCOPE_WORKGROUP); const int lp1 = __hip_atomic_fetch_add(&lc[LC_LCNT + 8 + i1], 1, __ATOMIC_RELAXED, __HIP_MEMORY_SCOPE_WORKGROUP);
                        e0k = i0; e1k = i1; p0k = lp0; p1k = lp1; }
                }
            }
          }
        }
        if constexpr (NS == 8) {
            __syncthreads();
            if (tid < 16) lc[LC_BASE + tid] = (int)__hip_atomic_fetch_add(ctl + CW_CNT + tid * 64, (unsigned)lc[LC_LCNT + tid], RLX_AGENT);
            __syncthreads();
            if (lane < 16) { int* list = (int*)(a.ws + WS_LIST);
                list[(0 * 8 + e0k) * 32768 + lc[LC_BASE + e0k] + p0k] = row0 + lane;
                list[(1 * 8 + e1k) * 32768 + lc[LC_BASE + 8 + e1k] + p1k] = row0 + lane; }
            __syncthreads();
        }
    }
}

DI u32x4 ldg16(const bf16* p) { return *(const u32x4*)p; }

DI void conv_tile(KArgsR a, int l, int b, int t0, int tid) {
    const bf16* z = (const bf16*)(a.ws + WS_Z); bf16* y = (bf16*)(a.ws + WS_Y);
    const float* cw = (const float*)a.in[I_CONVW] + l * 3 * 256;
    for (int it = tid; it < 64 * 32; it += 512) {
        const int tl = it >> 5, c8 = (it & 31) * 8, t = t0 + tl; const size_t row = (size_t)b * T + t;
        float acc[8];
#pragma unroll
        for (int i = 0; i < 8; ++i) acc[i] = 0.f;
#pragma unroll
        for (int jj = 0; jj < 3; ++jj) { const int tt = t - 2 + jj;
            if (tt >= 0) { const size_t r2 = (size_t)b * T + tt; const u32x4 gc = ldg16(z + r2 * NZ + ZC_CC + c8), uu = ldg16(z + r2 * NZ + ZC_CU + c8);
                const f32x4 w0 = *(const f32x4*)(cw + jj * 256 + c8), w1 = *(const f32x4*)(cw + jj * 256 + c8 + 4);
                acc[0] += w0.x * (bflo(gc.x) * bflo(uu.x)); acc[1] += w0.y * (bfhi(gc.x) * bfhi(uu.x)); acc[2] += w0.z * (bflo(gc.y) * bflo(uu.y)); acc[3] += w0.w * (bfhi(gc.y) * bfhi(uu.y));
                acc[4] += w1.x * (bflo(gc.z) * bflo(uu.z)); acc[5] += w1.y * (bfhi(gc.z) * bfhi(uu.z)); acc[6] += w1.z * (bflo(gc.w) * bflo(uu.w)); acc[7] += w1.w * (bfhi(gc.w) * bfhi(uu.w)); } }
        const u32x4 gb = ldg16(z + row * NZ + ZC_CB + c8);
        u32x4 o; o.x = pk2(bflo(gb.x) * acc[0], bfhi(gb.x) * acc[1]); o.y = pk2(bflo(gb.y) * acc[2], bfhi(gb.y) * acc[3]); o.z = pk2(bflo(gb.z) * acc[4], bfhi(gb.z) * acc[5]); o.w = pk2(bflo(gb.w) * acc[6], bfhi(gb.w) * acc[7]);
        *(u32x4*)(y + row * D + c8) = o;
    }
}
DI float norm_rope(float x, float gain, float cs, float sn, int lane) {
    const float ss = wave_sum(x * x); const float r = rsqrtf(ss * (1.f / 64.f) + RMS_EPS);
    const float xn = x * r * gain; const float pr = __shfl_xor(xn, 32);
    return (lane < 32) ? (xn * cs - pr * sn) : (xn * cs + pr * sn);
}
DI void rope_cs(int pos, int lane, float& cs, float& sn) {
    const int i = lane & 31; const float inv = exp2f(-(float)i * (13.287712379549449f / 32.f));
    const float ang = (float)pos * inv; sincosf(ang, &sn, &cs);
}
DI void prep_tile(KArgsR a, int l, int b, int t0, LAS unsigned char* lds, int tid, int lane, int wave) {
    bf16* z = (bf16*)(a.ws + WS_Z);
    const int hs = lane >> 5, lp = lane & 31, d0 = 2 * lp;
    const f32x2 qg2 = *(const f32x2*)((const float*)a.in[I_QNG] + l * 64 + d0), kg2 = *(const f32x2*)((const float*)a.in[I_KNG] + l * 64 + d0);
    const f32x2* ropet = (const f32x2*)((unsigned char*)a.out + OB_ROPE);
    const int tro = ((d0 >> 4) * 64 + 32 * ((d0 >> 3) & 1)) * 8 + (d0 & 7);
    unsigned nraw[4], nrawk[2]; f32x4 ncs;
#define PT_COL(sl_) ((sl_) < 2 ? ZC_NQ + (2 * (sl_) + hs) * 64 : ((sl_) == 2 ? ZC_KV + 2 * 128 + hs * 64 : ZC_KV + 4 * 128 + hs * 64))
#define PT_LOAD(i_) do { const size_t row_ = (size_t)b * T + t0 + wave * 8 + (i_); \
        _Pragma("unroll") for (int sl = 0; sl < 4; ++sl) nraw[sl] = *(const unsigned*)(z + row_ * NZ + PT_COL(sl) + d0); \
        _Pragma("unroll") for (int pk = 0; pk < 2; ++pk) nrawk[pk] = *(const unsigned*)(z + row_ * NZ + ZC_SBK + (2 * pk + hs) * 64 + d0); \
        ncs = *(const f32x4*)(ropet + row_ * 32 + (d0 & 31)); } while (0)
    PT_LOAD(0);
#pragma unroll 1
    for (int i = 0; i < 8; ++i) {
        const int t = t0 + wave * 8 + i; const size_t row = (size_t)b * T + t;
        unsigned raw[4], rawk[2];
#pragma unroll
        for (int sl = 0; sl < 4; ++sl) raw[sl] = nraw[sl];
#pragma unroll
        for (int pk = 0; pk < 2; ++pk) rawk[pk] = nrawk[pk];
        const f32x4 csn = ncs;
        if (i < 7) PT_LOAD(i + 1);
        const size_t tpos = (size_t)(t >> 5) * 2048 + (size_t)(t & 31) * 8 + tro;
#pragma unroll
        for (int pk = 0; pk < 2; ++pk) { bf16* kf = (bf16*)((unsigned char*)a.out + OB_KFSB) + (size_t)(b * 4 + 2 * pk + hs) * T * 64;
            *(unsigned*)(kf + tpos) = rawk[pk]; }
#pragma unroll
        for (int sl = 0; sl < 4; ++sl) {
            const float x0 = bflo(raw[sl]), x1 = bfhi(raw[sl]);
            float ss = x0 * x0 + x1 * x1;
            ss += WR_DPP(ss, 0xB1); ss += WR_DPP(ss, 0x4E); ss += WR_DPP(ss, 0x141); ss += WR_DPP(ss, 0x140); ss += __shfl_xor(ss, 16);
            const float r = rsqrtf(ss * (1.f / 64.f) + RMS_EPS);
            const float xn0 = x0 * r * (sl < 2 ? qg2.x : kg2.x), xn1 = x1 * r * (sl < 2 ? qg2.y : kg2.y);
            const float p0 = __shfl_xor(xn0, 16), p1 = __shfl_xor(xn1, 16);
            const float o0 = (lp < 16) ? (xn0 * csn.x - p0 * csn.y) : (xn0 * csn.x + p0 * csn.y), o1 = (lp < 16) ? (xn1 * csn.z - p1 * csn.w) : (xn1 * csn.z + p1 * csn.w);
            const unsigned pkd = pk2(o0, o1);
            *(unsigned*)(z + row * NZ + PT_COL(sl) + d0) = pkd;
            if (sl >= 2) {
                bf16* kf = (bf16*)((unsigned char*)a.out + (sl == 2 ? OB_KFSLC : OB_KFWIN)) + (size_t)(b * 2 + hs) * T * 64;
                *(unsigned*)(kf + tpos) = pkd; }
        }
    }
#undef PT_LOAD
#undef PT_COL
    LAS unsigned* scr = (LAS unsigned*)(lds + 32768 + wave * 1280);
    u32x4 vv[8];
#pragma unroll
    for (int k = 0; k < 8; ++k) { const int c0 = 8 * (wave + 8 * k); int zc0;
        if (c0 < 256) zc0 = ZC_SBV + c0; else if (c0 < 384) zc0 = ZC_KV + 3 * 128 + (c0 - 256); else zc0 = ZC_KV + 5 * 128 + (c0 - 384);
        vv[k] = *(const u32x4*)(z + ((size_t)b * T + t0 + lane) * NZ + zc0); }
#pragma unroll
    for (int k = 0; k < 8; ++k) {
        const int cb = wave + 8 * k, c0 = 8 * cb; const u32x4 v = vv[k];
        scr[lane * 5 + 0] = v.x; scr[lane * 5 + 1] = v.y; scr[lane * 5 + 2] = v.z; scr[lane * 5 + 3] = v.w;
        LDS_WAIT();
        const int ch = lane >> 3, o = lane & 7; const LAS bf16* sp = (const LAS bf16*)scr + ch;
        unsigned e[8];
#pragma unroll
        for (int j = 0; j < 8; ++j) e[j] = sp[(8 * o + j) * 10];
        const int c = c0 + ch, d = c & 63, key = t0 + 8 * o, kt = key >> 5, kk = key & 31, sp2 = kk >> 4, jh = (kk >> 3) & 1;
        bf16* base = (c < 256) ? (bf16*)((unsigned char*)a.out + OB_VFSB) + (size_t)(b * 4 + (c >> 6)) * T * 64 : (c < 384) ? (bf16*)((unsigned char*)a.out + OB_VFSLC) + (size_t)(b * 2 + ((c - 256) >> 6)) * T * 64 : (bf16*)((unsigned char*)a.out + OB_VFWIN) + (size_t)(b * 2 + ((c - 384) >> 6)) * T * 64;
        bf16* vf = base + ((size_t)((kt * 2 + (d >> 5)) * 2 + sp2) * 64 + (d & 31)) * 8 + 4 * jh;
        *(u32x2*)vf = (u32x2){e[0] | (e[1] << 16), e[2] | (e[3] << 16)};
        *(u32x2*)(vf + 32 * 8) = (u32x2){e[4] | (e[5] << 16), e[6] | (e[7] << 16)};
        LDS_WAIT();
    }
}

struct S5P { float lbr, lbi; float br[16], bi[16]; };
DI void s5_params(KArgsR a, int l, int g, int p, S5P& P) {
    const int gi = (l * 16 + g) * 64 + p;
    const float lre = fminf(((const float*)a.in[I_LRE])[gi], -1e-4f), lim = ((const float*)a.in[I_LIM])[gi];
    const float dt = expf(((const float*)a.in[I_LDT])[l * 16 + g]);
    const float mag = expf(lre * dt); float s, c; sincosf(lim * dt, &s, &c);
    P.lbr = mag * c; P.lbi = mag * s;
    const float nr = P.lbr - 1.f, ni = P.lbi, den = 1.f / (lre * lre + lim * lim);
    const float cr = (nr * lre + ni * lim) * den, ci = (ni * lre - nr * lim) * den;
    const float* bre = (const float*)a.in[I_BRE] + (size_t)gi * 16; const float* bim = (const float*)a.in[I_BIM] + (size_t)gi * 16;
#pragma unroll
    for (int q = 0; q < 4; ++q) { const f32x4 r4 = *(const f32x4*)(bre + 4 * q), i4 = *(const f32x4*)(bim + 4 * q);
#pragma unroll
        for (int j = 0; j < 4; ++j) { P.br[4 * q + j] = cr * r4[j] - ci * i4[j]; P.bi[4 * q + j] = cr * i4[j] + ci * r4[j]; } }
}
DI void s5_load_ublock(const bf16* z, int b, int tc0, LAS unsigned char* ub, int tid) {
#pragma unroll
    for (int k = 0; k < 4; ++k) { const int it = tid + 512 * k, r = it >> 5, c16 = it & 31;
        *(LAS u32x4*)(ub + r * 528 + c16 * 16) = *(const u32x4*)(z + ((size_t)b * T + tc0 + r) * NZ + ZC_SSM + c16 * 8); }
    LDS_BARRIER();
}
DI void s5_stage_u(const LAS unsigned char* ub, int g, LAS float* us, int lane) {
    const LAS u32x4* p = (const LAS u32x4*)(ub + lane * 528 + g * 32);
    const u32x4 v0 = p[0], v1 = p[1];
    LAS f32x4* d = (LAS f32x4*)(us + lane * 16);
    d[0] = (f32x4){bflo(v0.x), bfhi(v0.x), bflo(v0.y), bfhi(v0.y)}; d[1] = (f32x4){bflo(v0.z), bfhi(v0.z), bflo(v0.w), bfhi(v0.w)};
    d[2] = (f32x4){bflo(v1.x), bfhi(v1.x), bflo(v1.y), bfhi(v1.y)}; d[3] = (f32x4){bflo(v1.z), bfhi(v1.z), bflo(v1.w), bfhi(v1.w)};
    LDS_WAIT();
}
DI void s5_bu(const S5P& P, const LAS float* ut, float& bur, float& bui) {
    const f32x4 u0 = *(const LAS f32x4*)(ut), u1 = *(const LAS f32x4*)(ut + 4), u2 = *(const LAS f32x4*)(ut + 8), u3 = *(const LAS f32x4*)(ut + 12);
    float ar = 0.f, ai = 0.f, cr = 0.f, ci = 0.f;
#pragma unroll
    for (int j = 0; j < 4; ++j) { ar += P.br[j] * u0[j]; ai += P.bi[j] * u0[j]; cr += P.br[4 + j] * u1[j]; ci += P.bi[4 + j] * u1[j]; }
#pragma unroll
    for (int j = 0; j < 4; ++j) { ar += P.br[8 + j] * u2[j]; ai += P.bi[8 + j] * u2[j]; cr += P.br[12 + j] * u3[j]; ci += P.bi[12 + j] * u3[j]; }
    bur = ar + cr; bui = ai + ci;
}
DI void s5_rec(const S5P& P, float bur, float bui, float& hr, float& hi) { const float nr = P.lbr * hr - P.lbi * hi + bur, ni = P.lbr * hi + P.lbi * hr + bui; hr = nr; hi = ni; }
struct S5Raw { float lre, lim, ldt; f32x4 br4[4], bi4[4]; };
DI void s5_raw_load(KArgsR a, int l, int g, int p, S5Raw& R) {
    const int gi = (l * 16 + g) * 64 + p;
    R.lre = ((const float*)a.in[I_LRE])[gi]; R.lim = ((const float*)a.in[I_LIM])[gi]; R.ldt = ((const float*)a.in[I_LDT])[l * 16 + g];
    const float* bre = (const float*)a.in[I_BRE] + (size_t)gi * 16; const float* bim = (const float*)a.in[I_BIM] + (size_t)gi * 16;
#pragma unroll
    for (int q = 0; q < 4; ++q) { R.br4[q] = *(const f32x4*)(bre + 4 * q); R.bi4[q] = *(const f32x4*)(bim + 4 * q); }
}
DI void s5_raw_finish(const S5Raw& R, S5P& P) {
    const float lre = fminf(R.lre, -1e-4f), lim = R.lim;
    const float dt = expf(R.ldt);
    const float mag = expf(lre * dt); float s, c; sincosf(lim * dt, &s, &c);
    P.lbr = mag * c; P.lbi = mag * s;
    const float nr = P.lbr - 1.f, ni = P.lbi, den = 1.f / (lre * lre + lim * lim);
    const float cr = (nr * lre + ni * lim) * den, ci = (ni * lre - nr * lim) * den;
#pragma unroll
    for (int q = 0; q < 4; ++q)
#pragma unroll
        for (int j = 0; j < 4; ++j) { P.br[4 * q + j] = cr * R.br4[q][j] - ci * R.bi4[q][j]; P.bi[4 * q + j] = cr * R.bi4[q][j] + ci * R.br4[q][j]; }
}
DI void s5_cfrag(KArgsR a, int l, int g, int fr, int fq, bf16x8 (&Bf)[4], float& dsk) {
    const float* cre = (const float*)a.in[I_CRE] + ((size_t)(l * 16 + g) * 16 + fr) * 64; const float* cim = (const float*)a.in[I_CIM] + ((size_t)(l * 16 + g) * 16 + fr) * 64;
#pragma unroll
    for (int ks = 0; ks < 4; ++ks) { const f32x4 r4 = *(const f32x4*)(cre + 16 * ks + 4 * fq), i4 = *(const f32x4*)(cim + 16 * ks + 4 * fq);
        u32x4 w; w.x = pk2(r4.x, -i4.x); w.y = pk2(r4.y, -i4.y); w.z = pk2(r4.z, -i4.z); w.w = pk2(r4.w, -i4.w); Bf[ks] = __builtin_bit_cast(bf16x8, w); }
    dsk = ((const float*)a.in[I_SD])[l * 256 + g * 16 + fr];
}
typedef short s16x4 __attribute__((ext_vector_type(4)));
DI void s5_pass1(KArgsR a, int l, int b, int ch, LAS unsigned char* lds, int tid, int lane, int wave) {
    const bf16* z = (const bf16*)(a.ws + WS_Z);
    LAS unsigned char* BuL = lds + wave * 8704;
    LAS unsigned char* ub = lds + 69632;
    LAS unsigned* Hs = (LAS unsigned*)(lds + 103424 + wave * 4352);
    float* yl = (float*)((unsigned char*)a.out + OB_YL);
    asm volatile("" : "+v"(lane));
    const int fr = lane & 15, fq = lane >> 4, tc0 = ch * 64;
    S5Raw R0, R1;
    s5_raw_load(a, l, wave * 2, lane, R0);
    LDS_BARRIER();
    s5_load_ublock(z, b, tc0, ub, tid);
    s5_raw_load(a, l, wave * 2 + 1, lane, R1);
#pragma unroll
    for (int gg = 0; gg < 2; ++gg) {
        const int g = wave * 2 + gg; S5P P; s5_raw_finish(gg ? R1 : R0, P);
        bf16x8 Bf[4]; float dsk; s5_cfrag(a, l, g, fr, fq, Bf, dsk);
        { LAS u32x4* tp = (LAS u32x4*)(BuL + lane * 64);
          u32x4 w;
          w.x = pk2(P.br[0], P.br[1]); w.y = pk2(P.br[2], P.br[3]); w.z = pk2(P.br[4], P.br[5]); w.w = pk2(P.br[6], P.br[7]); tp[0] = w;
          w.x = pk2(P.br[8], P.br[9]); w.y = pk2(P.br[10], P.br[11]); w.z = pk2(P.br[12], P.br[13]); w.w = pk2(P.br[14], P.br[15]); tp[1] = w;
          w.x = pk2(P.bi[0], P.bi[1]); w.y = pk2(P.bi[2], P.bi[3]); w.z = pk2(P.bi[4], P.bi[5]); w.w = pk2(P.bi[6], P.bi[7]); tp[2] = w;
          w.x = pk2(P.bi[8], P.bi[9]); w.y = pk2(P.bi[10], P.bi[11]); w.z = pk2(P.bi[12], P.bi[13]); w.w = pk2(P.bi[14], P.bi[15]); tp[3] = w; }
        LDS_WAIT();
        s16x4 bfrag[4][2];
#pragma unroll
        for (int pb = 0; pb < 4; ++pb)
#pragma unroll
            for (int part = 0; part < 2; ++part) bfrag[pb][part] = __builtin_bit_cast(s16x4, *(const LAS u32x2*)(BuL + (16 * pb + fr) * 64 + part * 32 + fq * 8));
        LDS_WAIT();
        float hr = 0.f, hi = 0.f;
        for (int tb = 0; tb < 64; tb += 16) {
            const s16x4 af = __builtin_bit_cast(s16x4, *(const LAS u32x2*)(ub + (tb + fr) * 528 + g * 32 + fq * 8));
#pragma unroll
            for (int pb = 0; pb < 4; ++pb) {
                const f32x4 dre = __builtin_amdgcn_mfma_f32_16x16x16bf16_1k(af, bfrag[pb][0], (f32x4){0.f, 0.f, 0.f, 0.f}, 0, 0, 0);
                const f32x4 dim = __builtin_amdgcn_mfma_f32_16x16x16bf16_1k(af, bfrag[pb][1], (f32x4){0.f, 0.f, 0.f, 0.f}, 0, 0, 0);
#pragma unroll
                for (int r = 0; r < 4; ++r) *(LAS f32x2*)(BuL + ((4 * fq + r) * 68 + 16 * pb + fr) * 8) = (f32x2){dre[r], dim[r]}; }
            LDS_WAIT();
#pragma unroll 4
            for (int t = 0; t < 16; ++t) { const f32x2 bu = *(const LAS f32x2*)(BuL + (t * 68 + lane) * 8); s5_rec(P, bu.x, bu.y, hr, hi); Hs[t * 68 + lane] = pk2(hr, hi); }
            LDS_WAIT();
            f32x4 Y = (f32x4){0.f, 0.f, 0.f, 0.f};
#pragma unroll
            for (int ks = 0; ks < 4; ++ks) { const bf16x8 hf = __builtin_bit_cast(bf16x8, *(const LAS u32x4*)(Hs + fr * 68 + 16 * ks + 4 * fq)); Y = __builtin_amdgcn_mfma_f32_16x16x32_bf16(hf, Bf[ks], Y, 0, 0, 0); }
#pragma unroll
            for (int jj = 0; jj < 4; ++jj) { const int t = tb + 4 * fq + jj; const float uu = bf2f(*(const LAS bf16*)(ub + t * 528 + g * 32 + fr * 2));
                yl[((size_t)b * T + tc0 + t) * 256 + g * 16 + fr] = Y[jj] + dsk * uu; }
            LDS_WAIT();
        }
        ((f32x2*)(a.ws + WS_S5E))[((size_t)(b * 16 + g) * 128 + ch) * 64 + lane] = (f32x2){hr, hi};
        LDS_WAIT();
    }
}

DI void cmp_task(KArgsR a, int l, int task, LAS unsigned char* lds, int tid, int lane, int wave) {
    const int itile = task & 15, g = (task >> 4) & 1, b = (task >> 5) & 3, kv = task >> 7;
    const bf16* z = (const bf16*)(a.ws + WS_Z);
    const bf16* w1t = (const bf16*)(a.ws + WS_CW1) + (size_t)(l * 2 + kv) * 256 * 2048;
    const bf16* w2t = (const bf16*)(a.ws + WS_CW2) + (size_t)(l * 2 + kv) * 64 * 256;
    const float* cb = (const float*)(a.ws + WS_CBIAS) + (l * 2 + kv) * 256;
    LAS bf16* Hs = (LAS bf16*)lds;
    LAS float* Os = (LAS float*)(lds + 32 * 264 * 2);
    const int fr = lane & 15, fq = lane >> 4, i0 = itile * 32;
    const int zc = ZC_KV + kv * 128 + g * 64;
    f32x4 acc[2][2];
#pragma unroll
    for (int rb = 0; rb < 2; ++rb)
#pragma unroll
        for (int cbk = 0; cbk < 2; ++cbk) acc[rb][cbk] = (f32x4){0.f, 0.f, 0.f, 0.f};
    const bf16* arow[2];
#pragma unroll
    for (int rb = 0; rb < 2; ++rb) arow[rb] = z + ((size_t)b * T + 16 * (i0 + 16 * rb + fr)) * NZ + zc + 8 * fq;
    const bf16* brow[2];
#pragma unroll
    for (int cbk = 0; cbk < 2; ++cbk) brow[cbk] = w1t + ((size_t)(2 * wave + cbk) * 64 * 64 + lane) * 8;
#define CMP_LOAD(AF, BF, kb_) do { _Pragma("unroll") for (int u_ = 0; u_ < 4; ++u_) { const int ks_ = 4 * (kb_) + u_; const int j_ = ks_ >> 1, d0_ = (ks_ & 1) * 32; \
        _Pragma("unroll") for (int rb = 0; rb < 2; ++rb) AF[u_][rb] = *(const bf16x8*)(arow[rb] + (size_t)j_ * NZ + d0_); \
        _Pragma("unroll") for (int cbk = 0; cbk < 2; ++cbk) BF[u_][cbk] = *(const bf16x8*)(brow[cbk] + 512 * ks_); } } while (0)
#define CMP_MMA(AF, BF) do { __builtin_amdgcn_s_setprio(1); _Pragma("unroll") for (int u_ = 0; u_ < 4; ++u_) _Pragma("unroll") for (int rb = 0; rb < 2; ++rb) _Pragma("unroll") for (int cbk = 0; cbk < 2; ++cbk) \
        acc[rb][cbk] = __builtin_amdgcn_mfma_f32_16x16x32_bf16(AF[u_][rb], BF[u_][cbk], acc[rb][cbk], 0, 0, 0); __builtin_amdgcn_s_setprio(0); } while (0)
#ifdef DBL_G1
    for (int rep_ = 0; rep_ < 2; ++rep_) { asm volatile("" : "+v"(arow[0]), "+v"(brow[0])); if (rep_ == 1) { acc[0][0] = acc[0][1] = acc[1][0] = acc[1][1] = (f32x4){0.f, 0.f, 0.f, 0.f}; }
#else
    {
#endif
    { bf16x8 a0[4][2], b0[4][2], a1[4][2], b1[4][2];
      CMP_LOAD(a0, b0, 0);
#pragma unroll 1
      for (int kb = 0; kb < 16; kb += 2) {
          CMP_LOAD(a1, b1, kb + 1);
          CMP_MMA(a0, b0);
          if (kb + 2 < 16) CMP_LOAD(a0, b0, kb + 2);
          CMP_MMA(a1, b1);
      } }
    }
#undef CMP_LOAD
#undef CMP_MMA
#pragma unroll
    for (int rb = 0; rb < 2; ++rb)
#pragma unroll
        for (int cbk = 0; cbk < 2; ++cbk) { const int n = 32 * wave + 16 * cbk + fr; const float bias = cb[n];
#pragma unroll
            for (int jj = 0; jj < 4; ++jj) Hs[(16 * rb + 4 * fq + jj) * 264 + n] = (bf16)f2bf(siluf_(acc[rb][cbk][jj] + bias)); }
    LDS_BARRIER();
    { const int rb = wave >> 2, cbk = wave & 3; f32x4 o = (f32x4){0.f, 0.f, 0.f, 0.f};
#pragma unroll
        for (int ks = 0; ks < 8; ++ks) { const bf16x8 af = *(const LAS bf16x8*)(Hs + (16 * rb + fr) * 264 + 32 * ks + 8 * fq);
            const bf16x8 bfr = *(const bf16x8*)(w2t + (size_t)(16 * cbk + fr) * 256 + 32 * ks + 8 * fq);
            o = __builtin_amdgcn_mfma_f32_16x16x32_bf16(af, bfr, o, 0, 0, 0); }
#pragma unroll
        for (int jj = 0; jj < 4; ++jj) Os[(16 * rb + 4 * fq + jj) * 65 + 16 * cbk + fr] = o[jj]; }
    LDS_BARRIER();
    if (kv == 0) {
        const float kg = ((const float*)a.in[I_KNG])[l * 64 + lane];
        bf16* kf = (bf16*)(a.ws + WS_KC) + (size_t)(b * 2 + g) * 512 * 64;
#pragma unroll 1
        for (int r = 0; r < 4; ++r) { const int il = wave * 4 + r, i = i0 + il; float o = 0.f;
            if (i < NC) { const f32x2 csn = ((const f32x2*)((unsigned char*)a.out + OB_ROPE))[(size_t)(b * T + 16 * i + 31) * 32 + (lane & 31)]; o = norm_rope(Os[il * 65 + lane], kg, csn.x, csn.y, lane); }
            kf[((size_t)((i >> 5) * 4 + (lane >> 4)) * 64 + (i & 31) + 32 * ((lane >> 3) & 1)) * 8 + (lane & 7)] = (bf16)f2bf(o); }
    } else {
        const int d = tid >> 3, i4 = (tid & 7) * 4;
        float v[4];
#pragma unroll
        for (int jj = 0; jj < 4; ++jj) v[jj] = (i0 + i4 + jj < NC) ? Os[(i4 + jj) * 65 + d] : 0.f;
        u32x2 w; w.x = pk2(v[0], v[1]); w.y = pk2(v[2], v[3]);
        const int key = i0 + i4, kt = key >> 5, kk = key & 31, sp = kk >> 4, jh = (kk >> 3) & 1, hh = (kk >> 2) & 1;
        bf16* vf = (bf16*)(a.ws + WS_VCT) + (size_t)(b * 2 + g) * 512 * 64 + ((size_t)((kt * 2 + (d >> 5)) * 2 + sp) * 64 + (d & 31) + 32 * hh) * 8 + 4 * jh;
        *(u32x2*)vf = w;
    }
    LDS_BARRIER();
}

DI void s5_carry(KArgsR a, int l, int bg, int lane, gu32* flag) {
    const int b = bg >> 4, g = bg & 15; S5P P; s5_params(a, l, g, lane, P);
    float lr = P.lbr, li = P.lbi;
#pragma unroll
    for (int i = 0; i < 6; ++i) { const float nr = lr * lr - li * li, t2 = lr * li, ni = t2 + t2; lr = nr; li = ni; }
    const f32x2* E = (const f32x2*)(a.ws + WS_S5E) + (size_t)(b * 16 + g) * 128 * 64 + lane;
    typedef GAS unsigned long long gu64;
    gu64* C = (gu64*)(a.ws + WS_S5C) + (size_t)(b * 16 + g) * 128 * 64 + lane;
    float hr = 0.f, hi = 0.f;
#pragma unroll 1
    for (int k0 = 0; k0 < 128; k0 += 8) {
        f32x2 e[8];
#pragma unroll
        for (int i = 0; i < 8; ++i) e[i] = E[(size_t)(k0 + i) * 64];
#pragma unroll
        for (int i = 0; i < 8; ++i) {
            const unsigned long long bits = (unsigned long long)__builtin_bit_cast(unsigned, hr) | ((unsigned long long)__builtin_bit_cast(unsigned, hi) << 32);
            __hip_atomic_store(C + (size_t)(k0 + i) * 64, bits, RLX_AGENT);
            const float nr = lr * hr - li * hi + e[i].x, ni = lr * hi + li * hr + e[i].y; hr = nr; hi = ni; }
    }
    asm volatile("s_waitcnt vmcnt(0)" ::: "memory");
    if (lane == 0) __hip_atomic_fetch_add(flag, 1u, RLX_AGENT);
}
DI void s5_carry_wait(gu32* flag, int tid) {
    if (tid == 0) { unsigned sp = 0; while (__hip_atomic_load(flag, RLX_AGENT) < 64u) { __builtin_amdgcn_s_sleep(2); if (++sp > (1u << 22)) break; }
        __builtin_amdgcn_fence(__ATOMIC_ACQUIRE, "agent"); asm volatile("s_waitcnt vmcnt(0)" ::: "memory"); }
    __syncthreads();
}
DI void s5_pass2(KArgsR a, int l, int b, int ch, LAS unsigned char* lds, int tid, int lane, int wave) {
    bf16* y = (bf16*)(a.ws + WS_Y);
    LAS bf16* Gt = (LAS bf16*)lds;
    LAS unsigned* Hs = (LAS unsigned*)(lds + 34816 + wave * 8704 + 4096);
    const float* yl = (const float*)((unsigned char*)a.out + OB_YL);
    asm volatile("" : "+v"(lane));
    const int fr = lane & 15, fq = lane >> 4, tc0 = ch * 64;
    float lre2[2], lim2[2], ldt2[2]; f32x2 c02[2]; f32x4 cr4[2][4], ci4[2][4]; float ylv[2][4][4];
#pragma unroll
    for (int gg = 0; gg < 2; ++gg) { const int g = wave * 2 + gg, gi = (l * 16 + g) * 64 + lane;
        lre2[gg] = ((const float*)a.in[I_LRE])[gi]; lim2[gg] = ((const float*)a.in[I_LIM])[gi]; ldt2[gg] = ((const float*)a.in[I_LDT])[l * 16 + g];
        c02[gg] = ((const f32x2*)(a.ws + WS_S5C))[((size_t)(b * 16 + g) * 128 + ch) * 64 + lane];
        const float* cre = (const float*)a.in[I_CRE] + ((size_t)(l * 16 + g) * 16 + fr) * 64; const float* cim = (const float*)a.in[I_CIM] + ((size_t)(l * 16 + g) * 16 + fr) * 64;
#pragma unroll
        for (int ks = 0; ks < 4; ++ks) { cr4[gg][ks] = *(const f32x4*)(cre + 16 * ks + 4 * fq); ci4[gg][ks] = *(const f32x4*)(cim + 16 * ks + 4 * fq); }
#pragma unroll
        for (int tb4 = 0; tb4 < 4; ++tb4)
#pragma unroll
            for (int jj = 0; jj < 4; ++jj) ylv[gg][tb4][jj] = yl[((size_t)b * T + tc0 + 16 * tb4 + 4 * fq + jj) * 256 + g * 16 + fr]; }
#pragma unroll
    for (int gg = 0; gg < 2; ++gg) {
        const int g = wave * 2 + gg;
        float lbr, lbi;
        { const float lre = fminf(lre2[gg], -1e-4f), lim = lim2[gg]; const float dt = expf(ldt2[gg]); const float mag = expf(lre * dt); float s, c; sincosf(lim * dt, &s, &c); lbr = mag * c; lbi = mag * s; }
        float wr = c02[gg].x, wi = c02[gg].y;
        bf16x8 Bf[4];
#pragma unroll
        for (int ks = 0; ks < 4; ++ks) { const f32x4 r4 = cr4[gg][ks], i4 = ci4[gg][ks];
            u32x4 w; w.x = pk2(r4.x, -i4.x); w.y = pk2(r4.y, -i4.y); w.z = pk2(r4.z, -i4.z); w.w = pk2(r4.w, -i4.w); Bf[ks] = __builtin_bit_cast(bf16x8, w); }
#pragma unroll
        for (int tb4 = 0; tb4 < 4; ++tb4) { const int tb = 16 * tb4;
#pragma unroll 4
            for (int t = 0; t < 16; ++t) { const float nr = lbr * wr - lbi * wi, ni = lbr * wi + lbi * wr; wr = nr; wi = ni; Hs[t * 68 + lane] = pk2(wr, wi); }
            LDS_WAIT();
            f32x4 Y = (f32x4){0.f, 0.f, 0.f, 0.f};
#pragma unroll
            for (int ks = 0; ks < 4; ++ks) { const bf16x8 af = __builtin_bit_cast(bf16x8, *(const LAS u32x4*)(Hs + fr * 68 + 16 * ks + 4 * fq)); Y = __builtin_amdgcn_mfma_f32_16x16x32_bf16(af, Bf[ks], Y, 0, 0, 0); }
#pragma unroll
            for (int jj = 0; jj < 4; ++jj) { const int t = tb + 4 * fq + jj; Gt[t * 264 + g * 16 + fr] = (bf16)f2bf(gelu_tanh(Y[jj] + ylv[gg][tb4][jj])); }
            LDS_WAIT();
        }
    }
    LDS_BARRIER();
    { const bf16* wg = (const bf16*)(a.ws + WS_WGLU) + (size_t)l * 256 * 256;
        f32x4 acc[4][2];
#pragma unroll
        for (int rb = 0; rb < 4; ++rb)
#pragma unroll
            for (int cbk = 0; cbk < 2; ++cbk) acc[rb][cbk] = (f32x4){0.f, 0.f, 0.f, 0.f};
#pragma unroll 2
        for (int ks = 0; ks < 8; ++ks) {
            bf16x8 bfr[2];
#pragma unroll
            for (int cbk = 0; cbk < 2; ++cbk) bfr[cbk] = *(const bf16x8*)(wg + (size_t)(32 * wave + 16 * cbk + fr) * 256 + 32 * ks + 8 * fq);
#pragma unroll
            for (int rb = 0; rb < 4; ++rb) { const bf16x8 af = *(const LAS bf16x8*)(Gt + (16 * rb + fr) * 264 + 32 * ks + 8 * fq);
#pragma unroll
                for (int cbk = 0; cbk < 2; ++cbk) { __builtin_amdgcn_s_setprio(1); acc[rb][cbk] = __builtin_amdgcn_mfma_f32_16x16x32_bf16(af, bfr[cbk], acc[rb][cbk], 0, 0, 0); __builtin_amdgcn_s_setprio(0); } }
        }
#pragma unroll
        for (int rb = 0; rb < 4; ++rb)
#pragma unroll
            for (int cbk = 0; cbk < 2; ++cbk)
#pragma unroll
                for (int jj = 0; jj < 4; ++jj) { const int t = 16 * rb + 4 * fq + jj, n = 32 * wave + 16 * cbk + fr;
                    const float gv = bf2f(Gt[t * 264 + n]);
                    y[((size_t)b * T + tc0 + t) * D + 256 + n] = (bf16)f2bf(gv * sigmoidf_(acc[rb][cbk][jj])); }
    }
    LDS_BARRIER();
}

#define MFMA32(a, b, c) __builtin_amdgcn_mfma_f32_32x32x16_bf16((a), (b), (c), 0, 0, 0)
DI void ld_frag4(bf16x8 (&f)[4], const bf16* rowp, int h) {
#pragma unroll
    for (int s = 0; s < 4; ++s) f[s] = *(const bf16x8*)(rowp + 16 * s + 8 * h);
}
DI bf16x8 pack8(const float* p) { u32x4 w; w.x = pk2(p[0], p[1]); w.y = pk2(p[2], p[3]); w.z = pk2(p[4], p[5]); w.w = pk2(p[6], p[7]); return __builtin_bit_cast(bf16x8, w); }
DI f32x16 zero16() { f32x16 z;
#pragma unroll
    for (int i = 0; i < 16; ++i) z[i] = 0.f; return z; }

DI void sb_task(KArgsR a, int task, int lane) {
    const int qt = 255 - (task >> 4), b = (task >> 2) & 3, hd = task & 3;
    const bf16* z = (const bf16*)(a.ws + WS_Z); bf16* y = (bf16*)(a.ws + WS_Y);
    const int q = lane & 31, h = lane >> 5, t0 = qt * 32, t = t0 + q;
    bf16x8 Qf[4]; ld_frag4(Qf, z + ((size_t)b * T + t) * NZ + ZC_SBQ + hd * 64, h);
    const bf16* kfb = (const bf16*)((unsigned char*)a.out + OB_KFSB) + (size_t)(b * 4 + hd) * T * 64 + (size_t)lane * 8;
    const bf16* vfb = (const bf16*)((unsigned char*)a.out + OB_VFSB) + (size_t)(b * 4 + hd) * T * 64 + (size_t)lane * 8;
    f32x16 O0 = zero16(), O1 = zero16();
    float A = 0.f;
    bf16x8 Kn[4], Vn[4];
#pragma unroll
    for (int f = 0; f < 4; ++f) { Kn[f] = *(const bf16x8*)(kfb + (size_t)(qt * 4 + f) * 512); Vn[f] = *(const bf16x8*)(vfb + (size_t)(qt * 4 + f) * 512); }
    for (int kt = qt; kt >= 0; --kt) {
        const int key0 = kt * 32;
        bf16x8 Kf[4], V0[2], V1[2];
#pragma unroll
        for (int f = 0; f < 4; ++f) Kf[f] = Kn[f];
        V0[0] = Vn[0]; V0[1] = Vn[1]; V1[0] = Vn[2]; V1[1] = Vn[3];
        if (kt > 0) {
#pragma unroll
            for (int f = 0; f < 4; ++f) { Kn[f] = *(const bf16x8*)(kfb + (size_t)((kt - 1) * 4 + f) * 512); Vn[f] = *(const bf16x8*)(vfb + (size_t)((kt - 1) * 4 + f) * 512); } }
        f32x16 S = zero16();
        { __builtin_amdgcn_s_setprio(1); _Pragma("unroll") for (int s = 0; s < 4; ++s) S = MFMA32(Kf[s], Qf[s], S); __builtin_amdgcn_s_setprio(0); }
        float ls[16], lk[16];
#pragma unroll
        for (int i = 0; i < 16; ++i) { const int key = key0 + crow(i, h); const bool valid = key < t;
            const float zz = S[i] * 0.125f; const float e = fexp2(-fabsf(zz) * LOG2E); const float l1p = __builtin_amdgcn_logf(1.f + e) * LN2;
            ls[i] = fminf(zz, 0.f) - l1p;
            lk[i] = valid ? (ls[i] - zz) : 0.f; }
        float Gs[4], Gp[4];
#pragma unroll
        for (int g4 = 0; g4 < 4; ++g4) { Gs[g4] = (lk[4 * g4] + lk[4 * g4 + 1]) + (lk[4 * g4 + 2] + lk[4 * g4 + 3]); Gp[g4] = __shfl_xor(Gs[g4], 32); }
        float w[16]; float after = 0.f;
#pragma unroll
        for (int g4 = 3; g4 >= 0; --g4) {
            const float base = A + after + (h == 0 ? Gp[g4] : 0.f);
            float suf = 0.f;
#pragma unroll
            for (int jj = 3; jj >= 0; --jj) { const int i = 4 * g4 + jj; const int key = key0 + crow(i, h);
                const float lw = ls[i] + base + suf; w[i] = (key < t) ? fexp2(lw * LOG2E) : 0.f; suf += lk[i]; }
            after += Gs[g4] + Gp[g4];
        }
        A += after;
        const bf16x8 P0 = pack8(w), P1 = pack8(w + 8);
        __builtin_amdgcn_s_setprio(1); O0 = MFMA32(V0[0], P0, O0); O0 = MFMA32(V0[1], P1, O0); O1 = MFMA32(V1[0], P0, O1); O1 = MFMA32(V1[1], P1, O1); __builtin_amdgcn_s_setprio(0);
        if (__all(A < -40.f)) break;
    }
    bf16* yo = y + ((size_t)b * T + t) * D + 512 + hd * 64;
#pragma unroll
    for (int g4 = 0; g4 < 4; ++g4) { u32x2 w0, w1; w0.x = pk2(O0[4 * g4], O0[4 * g4 + 1]); w0.y = pk2(O0[4 * g4 + 2], O0[4 * g4 + 3]); w1.x = pk2(O1[4 * g4], O1[4 * g4 + 1]); w1.y = pk2(O1[4 * g4 + 2], O1[4 * g4 + 3]);
        *(u32x2*)(yo + 8 * g4 + 4 * h) = w0; *(u32x2*)(yo + 32 + 8 * g4 + 4 * h) = w1; }
}

DI unsigned wave_or(unsigned v) {
#pragma unroll
    for (int o = 1; o < 64; o <<= 1) v |= (unsigned)__shfl_xor((int)v, o);
    return v;
}
DI void nsa_block(KArgsR a, int l, int qs, int combo, LAS unsigned char* lds, LAS int* lc, int tid_in, int lane_in, int wave) {
    int tid = tid_in; asm volatile("" : "+v"(tid)); const int lane = tid & 63; (void)lane_in;
    const int b = (combo >> 1) & 3, g = combo & 1, hd_task = wave >> 2;
    const bf16* z = (const bf16*)(a.ws + WS_Z); bf16* y = (bf16*)(a.ws + WS_Y);
    LAS float* U = (LAS float*)(lds + wave * 16384);
    const int q = lane & 31, h = lane >> 5, qt = 4 * qs + (wave & 3), t0 = qt * 32, t = t0 + q, cur = t0 >> 6;
    const size_t rowq = (size_t)b * T + t;
    const float bq = wave_max(fabsf(((const float*)a.in[I_QNG])[l * 64 + lane])), bk = wave_max(fabsf(((const float*)a.in[I_KNG])[l * 64 + lane]));
    const float c1 = 0.125f * LOG2E, c2 = 8.f * bq * bk * LOG2E;
    for (int i = lane; i < 1024; i += 64) ((LAS f32x4*)U)[i] = (f32x4){0.f, 0.f, 0.f, 0.f};
    if (tid < 4) lc[LC_UNI + tid] = 0;
    LDS_BARRIER();
    const int imq = (t >= 31) ? ((t - 31) >> 4) : -1;
    const int ntc = (qs >> 2) + 1;
    const bf16* kcf = (const bf16*)(a.ws + WS_KC) + (size_t)(b * 2 + g) * 512 * 64 + (size_t)lane * 8;
    const bf16* vcf = (const bf16*)(a.ws + WS_VCT) + (size_t)(b * 2 + g) * 512 * 64 + (size_t)lane * 8;
    const int nfull_c = (qt > 0) ? ((((32 * qt - 31) >> 4) + 1) >> 5) : 0;
    float inv1;
    {
        bf16x8 Qf[4];
        ld_frag4(Qf, z + rowq * NZ + ZC_NQ + (2 * g + hd_task) * 64, h);
        float lsum = 0.f;
        bf16x8 Kn[4];
#pragma unroll
        for (int f = 0; f < 4; ++f) Kn[f] = *(const bf16x8*)(kcf + (size_t)f * 512);
#pragma unroll 1
        for (int it = 0; it < ntc; ++it) {
            bf16x8 Kf[4];
#pragma unroll
            for (int f = 0; f < 4; ++f) Kf[f] = Kn[f];
            if (it + 1 < ntc) {
#pragma unroll
                for (int f = 0; f < 4; ++f) Kn[f] = *(const bf16x8*)(kcf + (size_t)((it + 1) * 4 + f) * 512); }
            f32x16 S = zero16();
            { __builtin_amdgcn_s_setprio(1); _Pragma("unroll") for (int s = 0; s < 4; ++s) S = MFMA32(Kf[s], Qf[s], S); __builtin_amdgcn_s_setprio(0); }
            if (it < nfull_c) {
#pragma unroll
                for (int i = 0; i < 16; ++i) lsum += fexp2(S[i] * c1 - c2);
            } else {
#pragma unroll
                for (int i = 0; i < 16; ++i) { const int key = 32 * it + crow(i, h); lsum += (key <= imq) ? fexp2(S[i] * c1 - c2) : 0.f; } }
        }
        { const float s = lsum + __shfl_xor(lsum, 32); inv1 = (s > 0.f) ? 1.f / s : 0.f; }
        float carry = 0.f;
#pragma unroll
        for (int f = 0; f < 4; ++f) Kn[f] = *(const bf16x8*)(kcf + (size_t)f * 512);
#pragma unroll 1
        for (int it = 0; it < ntc; ++it) {
            bf16x8 Kf[4];
#pragma unroll
            for (int f = 0; f < 4; ++f) Kf[f] = Kn[f];
            if (it + 1 < ntc) {
#pragma unroll
                for (int f = 0; f < 4; ++f) Kn[f] = *(const bf16x8*)(kcf + (size_t)((it + 1) * 4 + f) * 512); }
            f32x16 S = zero16();
            { __builtin_amdgcn_s_setprio(1); _Pragma("unroll") for (int s = 0; s < 4; ++s) S = MFMA32(Kf[s], Qf[s], S); __builtin_amdgcn_s_setprio(0); }
            float p[16];
#pragma unroll
            for (int i = 0; i < 16; ++i) { const int key = 32 * it + crow(i, h); p[i] = (key <= imq) ? fexp2(S[i] * c1 - c2) * inv1 : 0.f; }
            float bnd[4];
#pragma unroll
            for (int g4 = 0; g4 < 4; ++g4) bnd[g4] = __shfl_xor(p[4 * g4 + 3], 32);
#pragma unroll
            for (int g4 = 0; g4 < 4; ++g4) { const float G4 = (p[4 * g4] + p[4 * g4 + 1]) + (p[4 * g4 + 2] + p[4 * g4 + 3]);
                const float extra = h ? bnd[g4] : (g4 ? bnd[g4 > 0 ? g4 - 1 : 0] : carry);
                const int sblk = 8 * it + 2 * g4 + h; U[sblk * 32 + q] += G4 + extra; }
            carry = bnd[3];
        }
    }
    {
        const LAS f32x4* Up = (const LAS f32x4*)(lds + (wave ^ 4) * 16384);
        LDS_BARRIER();
        f32x4 tmp[16];
#pragma unroll
        for (int i = 0; i < 16; ++i) tmp[i] = Up[lane + 64 * i];
        LDS_BARRIER();
#pragma unroll
        for (int i = 0; i < 16; ++i) ((LAS f32x4*)U)[lane + 64 * i] += tmp[i];
    }
    unsigned m0 = 0, m1 = 0, m2 = 0, m3 = 0;
    int tsel = tid; asm volatile("" : "+v"(tsel)); const int qsl = tsel & 31, hsl = (tsel >> 5) & 1;
#define SETBIT(idx) do { const int _i = (idx); const unsigned _b = 1u << (_i & 31); const int _w = _i >> 5; m0 |= (_w == 0) ? _b : 0u; m1 |= (_w == 1) ? _b : 0u; m2 |= (_w == 2) ? _b : 0u; m3 |= (_w == 3) ? _b : 0u; } while (0)
    if (cur <= 15) { m0 = (2u << cur) - 1u; }
    else {
        SETBIT(0); SETBIT(cur - 1); SETBIT(cur);
        const int mid = (cur + 1) >> 1; const int lo = hsl ? mid : 1, hi_ = hsl ? cur - 1 : mid;
#pragma unroll 1
        for (int r = 0; r < 13; ++r) {
            float bv = -2.f; int bi = 1 << 20;
#pragma unroll 8
            for (int s = lo; s < hi_; ++s) { const float v = U[s * 32 + qsl]; if (v > bv) { bv = v; bi = s; } }
            const float pv = __shfl_xor(bv, 32); const int pi = __shfl_xor(bi, 32);
            const bool takep = (pv > bv) || (pv == bv && pi < bi);
            const int wi = takep ? pi : bi;
            if (!takep) U[wi * 32 + qsl] = -1.f;
            SETBIT(wi);
        }
    }
#undef SETBIT
    const unsigned u0 = __builtin_amdgcn_readfirstlane(wave_or(m0)), u1 = __builtin_amdgcn_readfirstlane(wave_or(m1)), u2 = __builtin_amdgcn_readfirstlane(wave_or(m2)), u3 = __builtin_amdgcn_readfirstlane(wave_or(m3));
    if (lane == 0) { __hip_atomic_fetch_or((LAS unsigned*)&lc[LC_UNI + 0], u0, __ATOMIC_RELAXED, __HIP_MEMORY_SCOPE_WORKGROUP); __hip_atomic_fetch_or((LAS unsigned*)&lc[LC_UNI + 1], u1, __ATOMIC_RELAXED, __HIP_MEMORY_SCOPE_WORKGROUP);
        __hip_atomic_fetch_or((LAS unsigned*)&lc[LC_UNI + 2], u2, __ATOMIC_RELAXED, __HIP_MEMORY_SCOPE_WORKGROUP); __hip_atomic_fetch_or((LAS unsigned*)&lc[LC_UNI + 3], u3, __ATOMIC_RELAXED, __HIP_MEMORY_SCOPE_WORKGROUP); }
    LDS_BARRIER();
    if (tid < 128) {
        const unsigned w0 = (unsigned)lc[LC_UNI + 0], w1 = (unsigned)lc[LC_UNI + 1], w2 = (unsigned)lc[LC_UNI + 2], w3 = (unsigned)lc[LC_UNI + 3];
        const int wd = tid >> 5, bit = tid & 31; const unsigned uw = (wd == 0) ? w0 : (wd == 1) ? w1 : (wd == 2) ? w2 : w3;
        const int below = (wd > 0 ? __builtin_popcount(w0) : 0) + (wd > 1 ? __builtin_popcount(w1) : 0) + (wd > 2 ? __builtin_popcount(w2) : 0) + __builtin_popcount(uw & ((1u << bit) - 1u));
        if ((uw >> bit) & 1u) lc[LC_BLIST + below] = tid;
        if (tid == 0) lc[LC_UNI + 4] = __builtin_popcount(w0) + __builtin_popcount(w1) + __builtin_popcount(w2) + __builtin_popcount(w3); }
    LDS_BARRIER();
    const int nblk = __builtin_amdgcn_readfirstlane(lc[LC_UNI + 4]);
    { const int hd = hd_task;
        const int head = 2 * g + hd;
        int tl = tid; asm volatile("" : "+v"(tl));
        const int ql = tl & 31, hl = (tl >> 5) & 1; const size_t rowq2 = (size_t)b * T + t0 + ql;
        bf16x8 Qf[4]; ld_frag4(Qf, z + rowq2 * NZ + ZC_NQ + head * 64, hl);
        const float* glp = (const float*)(a.ws + WS_GL) + rowq2 * 12 + head * 3;
        const float gc = sigmoidf_(glp[0]), gs = sigmoidf_(glp[1]), gw = sigmoidf_(glp[2]);
        f32x16 F0, F1;
        {
            LAS unsigned char* slots = lds;
            LAS int* cntj = (LAS int*)(lds + 69632);
            LAS int* ibj = (LAS int*)(lds + 70144);
            LAS unsigned char* qlist = lds + 70656;
            LAS unsigned short* tab = (LAS unsigned short*)(lds + 103424);
            LAS unsigned char* Qs = lds + 111616;
            if (tid < 128) cntj[tid] = 0;
#pragma unroll
            for (int sv = 0; sv < 4; ++sv) *(LAS bf16x8*)(Qs + (wave * 32 + ql) * 144 + (16 * sv + 8 * hl) * 2) = Qf[sv];
            LDS_BARRIER();
            int ncon = 0;
            { const int qloc = wave * 32 + ql;
#pragma unroll 1
                for (int wd = 0; wd < 4; ++wd) { unsigned mm = (wd == 0) ? m0 : (wd == 1) ? m1 : (wd == 2) ? m2 : m3;
                    while (mm) { const int bit = __builtin_ctz(mm); mm &= mm - 1u; const int j = wd * 32 + bit;
                        if (hl == 0) { const int pos = __hip_atomic_fetch_add(&cntj[j], 1, __ATOMIC_RELAXED, __HIP_MEMORY_SCOPE_WORKGROUP); qlist[j * 256 + pos] = (unsigned char)qloc; tab[qloc * 16 + ncon] = (unsigned short)(j | (pos << 7)); }
                        ++ncon; } } }
            LDS_BARRIER();
            {
                int ng = 0, jb = 0, cjb = 0;
                if (tid < 128 && tid < nblk) { jb = lc[LC_BLIST + tid]; cjb = cntj[jb]; ng = (cjb + 31) >> 5; }
                int incl = ng;
#pragma unroll
                for (int o = 1; o < 64; o <<= 1) { const int v = __shfl_up(incl, o); if ((tl & 63) >= o) incl += v; }
                if (tid == 63) lc[LC_UNI + 7] = incl;
                LDS_BARRIER();
                if (tid < 128) { const int base = incl - ng + ((tid >= 64) ? lc[LC_UNI + 7] : 0);
                    if (tid < nblk) { ibj[jb] = base; for (int k = 0; k < ng; ++k) lc[LC_ITEMS + base + k] = jb | ((32 * k) << 8); }
                    if (tid == 127) lc[LC_UNI + 5] = base + ng; }
            }
            LDS_BARRIER();
            const int nitems = __builtin_amdgcn_readfirstlane(lc[LC_UNI + 5]); const int lane6 = tl & 63; const int nrounds = (nitems + 7) >> 3;
            const bf16* kfb = (const bf16*)((unsigned char*)a.out + OB_KFSLC) + (size_t)(b * 2 + g) * T * 64 + (size_t)lane6 * 8;
            const bf16* vfb = (const bf16*)((unsigned char*)a.out + OB_VFSLC) + (size_t)(b * 2 + g) * T * 64 + (size_t)lane6 * 8;
#define NSA_LDK(kb_, ktg) do { _Pragma("unroll") for (int f_ = 0; f_ < 4; ++f_) Kn[kb_][f_] = *(const bf16x8*)(kfb + (size_t)((ktg) * 4 + f_) * 512); } while (0)
#define NSA_LDV(kb_, ktg) do { _Pragma("unroll") for (int f_ = 0; f_ < 4; ++f_) Vn[kb_][f_] = *(const bf16x8*)(vfb + (size_t)((ktg) * 4 + f_) * 512); } while (0)
#define NSA_LDT(kb_, ktg) do { NSA_LDK(kb_, ktg); NSA_LDV(kb_, ktg); } while (0)
            bf16x8 Kn[2][4], Vn[2][4];
            if (wave < nitems) { const int j0 = __builtin_amdgcn_readfirstlane(lc[LC_ITEMS + wave]) & 255; NSA_LDT(0, 2 * j0); NSA_LDT(1, 2 * j0 + 1); }
            int kcur = 0; float lacc = 0.f;
#pragma unroll
            for (int i = 0; i < 16; ++i) { F0[i] = 0.f; F1[i] = 0.f; }
            const int qown = wave * 32 + ql;
#pragma unroll 1
            for (int r = 0; r <= nrounds; ++r) {
                if (r > 0) { const LAS unsigned char* sb = slots + ((r - 1) & 1) * 34816;
                    while (kcur < ncon) {
                        const int e = tab[qown * 16 + kcur]; const int j = e & 127, pos = e >> 7; const int item = ibj[j] + (pos >> 5);
                        if ((item >> 3) != r - 1) break;
                        const LAS unsigned char* sl = sb + ((item & 7) * 32 + (pos & 31)) * 136;
#pragma unroll
                        for (int g4 = 0; g4 < 4; ++g4) { const u32x2 a0 = *(const LAS u32x2*)(sl + 16 * g4 + 8 * hl), a1 = *(const LAS u32x2*)(sl + 64 + 16 * g4 + 8 * hl);
                            F0[4 * g4] += bflo(a0.x); F0[4 * g4 + 1] += bfhi(a0.x); F0[4 * g4 + 2] += bflo(a0.y); F0[4 * g4 + 3] += bfhi(a0.y);
                            F1[4 * g4] += bflo(a1.x); F1[4 * g4 + 1] += bfhi(a1.x); F1[4 * g4 + 2] += bflo(a1.y); F1[4 * g4 + 3] += bfhi(a1.y); }
                        lacc += *(const LAS float*)(sl + 128); ++kcur;
                    } }
                const int it = 8 * r + wave;
                if (r < nrounds && it < nitems) {
                    const int itm = __builtin_amdgcn_readfirstlane(lc[LC_ITEMS + it]); const int j = itm & 255, g0 = itm >> 8; const int cj = __builtin_amdgcn_readfirstlane(cntj[j]);
                    const int idx = g0 + ql; const bool valid = idx < cj; const int qloc = qlist[j * 256 + (valid ? idx : g0)];
                    const int tq = 128 * qs + (qloc & 127);
                    bf16x8 Qg[4];
#pragma unroll
                    for (int sv = 0; sv < 4; ++sv) Qg[sv] = *(const LAS bf16x8*)(Qs + qloc * 144 + (16 * sv + 8 * hl) * 2);
                    f32x16 O0 = zero16(), O1 = zero16(); float ls = 0.f;
                    const bool hn = it + 8 < nitems; const int jn = hn ? (__builtin_amdgcn_readfirstlane(lc[LC_ITEMS + it + 8]) & 255) : 0;
                    f32x16 S2[2]; S2[0] = zero16(); S2[1] = zero16();
                    __builtin_amdgcn_s_setprio(1);
#pragma unroll
                    for (int sv = 0; sv < 4; ++sv) { S2[0] = MFMA32(Kn[0][sv], Qg[sv], S2[0]); S2[1] = MFMA32(Kn[1][sv], Qg[sv], S2[1]); }
                    __builtin_amdgcn_s_setprio(0);
                    if (hn) { NSA_LDK(0, 2 * jn); NSA_LDK(1, 2 * jn + 1); }
#pragma unroll
                    for (int kt = 0; kt < 2; ++kt) { const int key0 = 64 * j + 32 * kt;
                        float p[16];
                        if (64 * j + 63 <= 128 * qs) {
#pragma unroll
                            for (int i = 0; i < 16; ++i) { p[i] = fexp2(S2[kt][i] * c1 - c2); ls += p[i]; }
                        } else {
#pragma unroll
                            for (int i = 0; i < 16; ++i) { const int key = key0 + crow(i, hl); p[i] = (valid && key <= tq) ? fexp2(S2[kt][i] * c1 - c2) : 0.f; ls += p[i]; }
                        }
                        const bf16x8 P0 = pack8(p), P1 = pack8(p + 8);
                        __builtin_amdgcn_s_setprio(1); O0 = MFMA32(Vn[kt][0], P0, O0); O0 = MFMA32(Vn[kt][1], P1, O0); O1 = MFMA32(Vn[kt][2], P0, O1); O1 = MFMA32(Vn[kt][3], P1, O1); __builtin_amdgcn_s_setprio(0);
                        if (hn) NSA_LDV(kt, 2 * jn + kt); }
                    ls += __shfl_xor(ls, 32);
                    LAS unsigned char* sl = slots + (r & 1) * 34816 + (wave * 32 + ql) * 136;
#pragma unroll
                    for (int g4 = 0; g4 < 4; ++g4) { u32x2 w0, w1; w0.x = pk2(O0[4 * g4], O0[4 * g4 + 1]); w0.y = pk2(O0[4 * g4 + 2], O0[4 * g4 + 3]); w1.x = pk2(O1[4 * g4], O1[4 * g4 + 1]); w1.y = pk2(O1[4 * g4 + 2], O1[4 * g4 + 3]);
                        *(LAS u32x2*)(sl + 16 * g4 + 8 * hl) = w0; *(LAS u32x2*)(sl + 64 + 16 * g4 + 8 * hl) = w1; }
                    if (hl == 0) *(LAS float*)(sl + 128) = ls;
                }
                LDS_BARRIER();
            }
#undef NSA_LDT
#undef NSA_LDK
#undef NSA_LDV
            { const float scl = gs / lacc; F0 = F0 * scl; F1 = F1 * scl; }
        }
        {
            f32x16 O0 = zero16(), O1 = zero16(); float ls = 0.f;
            bf16x8 Kn[4], Vn[4];
#pragma unroll
            for (int f = 0; f < 4; ++f) { Kn[f] = *(const bf16x8*)(kcf + (size_t)f * 512); Vn[f] = *(const bf16x8*)(vcf + (size_t)f * 512); }
#pragma unroll 1
            for (int it = 0; it < ntc; ++it) {
                bf16x8 Kf[4], Vf[4];
#pragma unroll
                for (int f = 0; f < 4; ++f) { Kf[f] = Kn[f]; Vf[f] = Vn[f]; }
                if (it + 1 < ntc) {
#pragma unroll
                    for (int f = 0; f < 4; ++f) { Kn[f] = *(const bf16x8*)(kcf + (size_t)((it + 1) * 4 + f) * 512); Vn[f] = *(const bf16x8*)(vcf + (size_t)((it + 1) * 4 + f) * 512); } }
                f32x16 S = zero16();
                { __builtin_amdgcn_s_setprio(1); _Pragma("unroll") for (int sv = 0; sv < 4; ++sv) S = MFMA32(Kf[sv], Qf[sv], S); __builtin_amdgcn_s_setprio(0); }
                float p[16];
                if (it < nfull_c) {
#pragma unroll
                    for (int i = 0; i < 16; ++i) { p[i] = fexp2(S[i] * c1 - c2); ls += p[i]; }
                } else {
#pragma unroll
                    for (int i = 0; i < 16; ++i) { const int key = 32 * it + crow(i, hl); p[i] = (key <= imq) ? fexp2(S[i] * c1 - c2) : 0.f; ls += p[i]; }
                }
                const bf16x8 P0 = pack8(p), P1 = pack8(p + 8);
                __builtin_amdgcn_s_setprio(1); O0 = MFMA32(Vf[0], P0, O0); O0 = MFMA32(Vf[1], P1, O0); O1 = MFMA32(Vf[2], P0, O1); O1 = MFMA32(Vf[3], P1, O1); __builtin_amdgcn_s_setprio(0);
            }
            ls += __shfl_xor(ls, 32); const float scl = (ls > 0.f) ? gc / ls : 0.f;
            F0 += O0 * scl; F1 += O1 * scl;
        }
        {
            f32x16 O0 = zero16(), O1 = zero16(); float ls = 0.f;
            const int lane6 = tl & 63;
            const bf16* kfw = (const bf16*)((unsigned char*)a.out + OB_KFWIN) + (size_t)(b * 2 + g) * T * 64 + (size_t)lane6 * 8;
            const bf16* vfw = (const bf16*)((unsigned char*)a.out + OB_VFWIN) + (size_t)(b * 2 + g) * T * 64 + (size_t)lane6 * 8;
            int ktw = qt - 16; if (ktw < 0) ktw = 0;
            bf16x8 Kn[2][4], Vn[2][4];
#define NSA_LDWK(kb_, ktg) do { _Pragma("unroll") for (int f_ = 0; f_ < 4; ++f_) Kn[kb_][f_] = *(const bf16x8*)(kfw + (size_t)((ktg) * 4 + f_) * 512); } while (0)
#define NSA_LDWV(kb_, ktg) do { _Pragma("unroll") for (int f_ = 0; f_ < 4; ++f_) Vn[kb_][f_] = *(const bf16x8*)(vfw + (size_t)((ktg) * 4 + f_) * 512); } while (0)
#define NSA_LDW(kb_, ktg) do { NSA_LDWK(kb_, ktg); NSA_LDWV(kb_, ktg); } while (0)
#define NSA_WSTEP(kb_, kt_) do { const int kt = (kt_); \
                f32x16 S = zero16(); \
                __builtin_amdgcn_s_setprio(1); _Pragma("unroll") for (int sv = 0; sv < 4; ++sv) S = MFMA32(Kn[kb_][sv], Qf[sv], S); __builtin_amdgcn_s_setprio(0); \
                if (kt + 2 <= qt) NSA_LDWK(kb_, kt + 2); \
                float p[16]; \
                if (kt > qt - 16 && kt < qt) {            \
                    _Pragma("unroll") for (int i = 0; i < 16; ++i) { p[i] = fexp2(S[i] * c1 - c2); ls += p[i]; } \
                } else { \
                    _Pragma("unroll") for (int i = 0; i < 16; ++i) { const int key = 32 * kt + crow(i, hl); p[i] = (key <= t && key > t - 512) ? fexp2(S[i] * c1 - c2) : 0.f; ls += p[i]; } \
                } \
                const bf16x8 P0 = pack8(p), P1 = pack8(p + 8); \
                __builtin_amdgcn_s_setprio(1); O0 = MFMA32(Vn[kb_][0], P0, O0); O0 = MFMA32(Vn[kb_][1], P1, O0); O1 = MFMA32(Vn[kb_][2], P0, O1); O1 = MFMA32(Vn[kb_][3], P1, O1); __builtin_amdgcn_s_setprio(0); \
                if (kt + 2 <= qt) NSA_LDWV(kb_, kt + 2); } while (0)
            NSA_LDW(0, ktw); if (ktw + 1 <= qt) NSA_LDW(1, ktw + 1);
#pragma unroll 1
            for (int kt0 = ktw; kt0 <= qt; kt0 += 2) {
                NSA_WSTEP(0, kt0);
                if (kt0 + 1 <= qt) NSA_WSTEP(1, kt0 + 1);
            }
#undef NSA_LDW
#undef NSA_LDWK
#undef NSA_LDWV
#undef NSA_WSTEP
            ls += __shfl_xor(ls, 32); const float scl = gw / ls;
            F0 += O0 * scl; F1 += O1 * scl;
        }
        bf16* yo = y + rowq2 * D + 768 + head * 64;
#pragma unroll
        for (int g4 = 0; g4 < 4; ++g4) { u32x2 w0, w1; w0.x = pk2(F0[4 * g4], F0[4 * g4 + 1]); w0.y = pk2(F0[4 * g4 + 2], F0[4 * g4 + 3]); w1.x = pk2(F1[4 * g4], F1[4 * g4 + 1]); w1.y = pk2(F1[4 * g4 + 2], F1[4 * g4 + 3]);
            *(u32x2*)(yo + 8 * g4 + 4 * h) = w0; *(u32x2*)(yo + 32 + 8 * g4 + 4 * h) = w1; }
    }
    LDS_BARRIER();
}
__device__ __attribute__((noinline)) void grid_bar_call(unsigned* bar, volatile LAS unsigned* st) { XcdBarrier b_; b_.bar = bar; b_.x = xb_xcc_id(); b_.st = st; xcd_barrier(b_); }
constexpr int DEPTH = 2;
typedef const __attribute__((address_space(4))) Args* KArgsP;
__global__ void __launch_bounds__(512, 2) fwd_kernel(Args a_in) {
    extern __shared__ __attribute__((aligned(16))) unsigned char lds_raw[];
    LAS unsigned char* lds = (LAS unsigned char*)lds_raw;
    int tid = threadIdx.x, lane = tid & 63; const int wave = __builtin_amdgcn_readfirstlane(tid >> 6), G = gridDim.x;
    LAS int* lc = (LAS int*)(lds + LDSCTL_OFF);
#define PHASE() tid = threadIdx.x; asm volatile("" : "+v"(tid)); lane = tid & 63; KArgsP kp_ = (KArgsP)__builtin_amdgcn_kernarg_segment_ptr(); asm volatile("" : "+s"(kp_)); KArgsR a = *kp_; \
    gu32* ctl = (gu32*)(a.ws + WS_CTL); f16* h = (f16*)(a.ws + WS_H16); const float* modl = (const float*)(a.ws + WS_MOD) + l * 4 * 6144; (void)ctl; (void)modl; (void)h
#define GRID_BAR() do { KArgsP kb_ = (KArgsP)__builtin_amdgcn_kernarg_segment_ptr(); asm volatile("" : "+s"(kb_)); grid_bar_call((unsigned*)(kb_->ws + WS_CTL) + CW_BAR, (volatile LAS unsigned*)(lc + LC_BAR)); } while (0)
#ifdef TP
    const unsigned long long t_start = __builtin_amdgcn_s_memrealtime();
#define TPOINT(k) do { if (TP == (k) && l == TPL) { while (__builtin_amdgcn_s_memrealtime() - t_start < 600000ull) __builtin_amdgcn_s_sleep(8); } } while (0)
#else
#define TPOINT(k) do { } while (0)
#endif
    for (int u = tid; u < (LDS_BYTES - LDSCTL_OFF) / 4; u += 512) lc[u] = 0;
    __syncthreads();
#ifdef CODE_WARM_N
    { const unsigned long long pc0 = __builtin_amdgcn_s_getpc(); if (tid == 0) { lc[LC_MISC + 4] = (int)(unsigned)pc0; lc[LC_MISC + 5] = (int)(unsigned)(pc0 >> 32); } __syncthreads(); }
#define CODE_WARM() do { if (wave == 1) { const unsigned* cp_ = (const unsigned*)((((unsigned long long)(unsigned)lc[LC_MISC + 4]) | ((unsigned long long)(unsigned)lc[LC_MISC + 5] << 32)) & ~127ull) + (threadIdx.x & 63) * 32; \
        _Pragma("unroll") for (int k_ = 0; k_ < CODE_WARM_N; ++k_) __builtin_amdgcn_global_load_lds(cp_ + k_ * 2048, (LAS unsigned*)(lds + LDSCTL_OFF + 3840), 4, 0, 0); } } while (0)
#else
#define CODE_WARM() do { } while (0)
#endif
    { const int l = 0; PHASE(); (void)xcd_barrier_post((unsigned*)(a.ws + WS_CTL) + CW_BAR, (volatile LAS unsigned*)(lc + LC_BAR));
      prologue(a, lds, tid, lane, wave, G);
    }
    GRID_BAR();

    for (int l = 0; l < DEPTH; ++l) {
        const int dense = (l == 0);
        TPOINT(0);
        { PHASE();
          int lg = 0; asm volatile("" : "+s"(lg));
          if (l == 0) norm_phase<12, false>(a, a.in[I_X], (const float*)a.in[I_NMG] + l * D, modl, 0, (const float*)a.in[I_WIN] + (size_t)l * D * NIN + NZ, NIN, lds, tid, lane, wave, G, 0, M, OB_A, lg != 0);
          else norm_phase<12, true>(a, h, (const float*)a.in[I_NMG] + l * D, modl, 0, (const float*)a.in[I_WIN] + (size_t)l * D * NIN + NZ, NIN, lds, tid, lane, wave, G, 0, M, OB_A, lg != 0); }
        GRID_BAR();
        TPOINT(10);
        { PHASE();
          pg8::Gemm g{(const bf16*)((unsigned char*)a.out + OB_A), (const bf16*)((unsigned char*)a.out + OB_WIN) + (size_t)l * NZP * D, M, NZP, D}; pg8::StaticOrder S; S.init(M, NZP, D, G, (int)blockIdx.x);
          EpiZ E{(bf16*)(a.ws + WS_Z), (float*)(a.ws + WS_GL)};
          pg8::gemm_phase<EpiZ, pg8::StaticOrder, true, false>(lds, g, S, E); }
        GRID_BAR();
        TPOINT(1);
        { PHASE(); for (int cb = blockIdx.x; cb < CMP_WGS; cb += G) for (int k = 0; k < 256 / CMP_WGS; ++k) cmp_task(a, l, cb * (256 / CMP_WGS) + k, lds, tid, lane, wave); }
        TPOINT(2);
        { PHASE(); gu32* qp = ctl + CW_Q + 64 * l; gu32* qs5 = qp + 16;
          const int prim = ((int)blockIdx.x < CMP_WGS) ? 1 : 0;
          int done0 = 0, done1 = 0;
          int which = prim; int nxt = 0;
          if (tid == 0) nxt = (int)__hip_atomic_fetch_add(which ? qs5 : qp, 1u, RLX_AGENT);
          for (;;) {
              LDS_BARRIER();
              if (tid == 0) lc[LC_MISC + 1] = nxt;
              LDS_BARRIER();
              const int task = __builtin_amdgcn_readfirstlane(lc[LC_MISC + 1]);
              if (task >= 512) { if (which) done1 = 1; else done0 = 1;
                  if (done0 && done1) break;
                  which ^= 1; if (tid == 0) nxt = (int)__hip_atomic_fetch_add(which ? qs5 : qp, 1u, RLX_AGENT); continue; }
              if (tid == 0) nxt = (int)__hip_atomic_fetch_add(which ? qs5 : qp, 1u, RLX_AGENT);
              int tq = threadIdx.x; asm volatile("" : "+v"(tq)); const int lq = tq & 63;
              if (which == 0) { const int b = task >> 7, t0 = (task & 127) * 64; conv_tile(a, l, b, t0, tq); prep_tile(a, l, b, t0, lds, tq, lq, wave); }
              else s5_pass1(a, l, task >> 7, task & 127, lds, tq, lq, wave); } }
        GRID_BAR();
        TPOINT(4);
        { PHASE(); for (int bg = (int)blockIdx.x * 8 + wave; bg < 64; bg += G * 8) s5_carry(a, l, bg, lane, ctl + CW_S5F + 64 * l); }
#ifdef REP_NSA
        for (int rep_ = 0; rep_ < REP_NSA; ++rep_)
#endif
        { PHASE(); for (int pr = blockIdx.x; pr < 256; pr += G) {
#pragma unroll 1
              for (int half = 0; half < 2; ++half) nsa_block(a, l, half ? (pr >> 3) : 63 - (pr >> 3), pr & 7, lds, lc, tid, lane, wave); } }
        TPOINT(5);
        { PHASE(); s5_carry_wait(ctl + CW_S5F + 64 * l, tid);
          gu32* q2 = ctl + CW_Q + 64 * l + 32;
          for (;;) {
              LDS_BARRIER();
              if (tid == 0) lc[LC_MISC + 1] = (int)__hip_atomic_fetch_add(q2, 1u, RLX_AGENT);
              LDS_BARRIER();
              const int task = __builtin_amdgcn_readfirstlane(lc[LC_MISC + 1]);
              if (task >= 512) break;
              int tq = threadIdx.x; asm volatile("" : "+v"(tq));
              s5_pass2(a, l, task >> 7, task & 127, lds, tq, tq & 63, wave); } }
        TPOINT(6);
        { PHASE(); gu32* q3 = ctl + CW_Q + 64 * l + 48;
          for (;;) {
              LDS_BARRIER();
              if (tid == 0) lc[LC_MISC + 1] = (int)__hip_atomic_fetch_add(q3, 1u, RLX_AGENT);
              LDS_BARRIER();
              const int c = __builtin_amdgcn_readfirstlane(lc[LC_MISC + 1]);
              if (c >= 512) break;
              sb_task(a, c * 8 + wave, lane); } }
        GRID_BAR();
        TPOINT(7);
        { PHASE();
          pg8::Gemm g{(const bf16*)(a.ws + WS_Y), (const bf16*)(a.ws + WS_WOUT) + (size_t)l * D * D, M, D, D}; pg8::StaticOrder S; S.init(M, D, D, G, (int)blockIdx.x);
          EpiRes E{l == 0 ? (const float*)a.in[I_X] : nullptr, h, modl};
          pg8::gemm_phase<EpiRes, pg8::StaticOrder, true, false>(lds, g, S, E); }
        GRID_BAR();
        TPOINT(8);
        { PHASE();
          if (dense) { norm_phase<0, true>(a, h, (const float*)a.in[I_NFG] + l * D, modl, 3072, nullptr, 0, lds, tid, lane, wave, G); }
          else { norm_phase<8, true>(a, h, (const float*)a.in[I_NFG] + l * D, modl, 3072, (const float*)a.in[I_MR], 8, lds, tid, lane, wave, G); } }
        GRID_BAR();
        TPOINT(9);
        const int npass = dense ? 1 : 2;
        for (int kp = 0; kp < npass; ++kp) {
            int nRT;
            { PHASE();
              if (tid == 0) {
                int rt = 0;
                if (dense) rt = 128;
                else for (int e = 0; e < 8; ++e) { const int c = (int)__hip_atomic_load(ctl + CW_CNT + (kp * 8 + e) * 64, RLX_AGENT); lc[LC_CNT + e] = c; const int nt_ = (c + 255) >> 8;
                    for (int i = 0; i < nt_; ++i) lc[LC_TILE + rt + i] = e | (i << 8); rt += nt_; }
                lc[LC_MISC] = rt;
              }
              __syncthreads();
              nRT = __builtin_amdgcn_readfirstlane(lc[LC_MISC]); }
            { PHASE(); const int* list = (const int*)(a.ws + WS_LIST) + (size_t)kp * 8 * 32768;
              pg8::Gemm g{(const bf16*)((unsigned char*)a.out + OB_A), dense ? (const bf16*)(a.ws + WS_WGUD) : (const bf16*)(a.ws + WS_WGUM), M, 7168, D};
              pg8::MoeOrder S; S.nRT = nRT; S.nN = 28; S.nwg = nRT * 28; S.G = G; S.c = (int)blockIdx.x; S.dense = dense; S.K2 = D * 2; S.tile_e = lc + LC_TILE; S.cnt = lc + LC_CNT; S.list = list; S.KT = D / 64; S.nfull = S.nwg; S.nsplit = 1;
              EpiSwiglu E{(bf16*)(a.ws + WS_HID)};
              pg8::gemm_phase<EpiSwiglu, pg8::MoeOrder, true, true>(lds, g, S, E); }
            GRID_BAR();
            int rem;
            { PHASE(); const int* list = (const int*)(a.ws + WS_LIST) + (size_t)kp * 8 * 32768;
              pg8::Gemm g{(const bf16*)(a.ws + WS_HID), dense ? (const bf16*)(a.ws + WS_WDD) : (const bf16*)(a.ws + WS_WDM), M, D, FF};
              pg8::MoeOrder S; S.nRT = nRT; S.nN = 4; S.nwg = nRT * 4; S.G = G; S.c = (int)blockIdx.x; S.dense = dense; S.K2 = FF * 2; S.tile_e = lc + LC_TILE; S.cnt = lc + LC_CNT; S.list = list;
              S.KT = FF / 64; S.nfull = (S.nwg / G) * G; S.nsplit = 7; rem = S.nwg - S.nfull; if (rem > 32) { S.nfull = S.nwg; rem = 0; }
              EpiDown E{h, a.out, modl, list, (const float*)(a.ws + WS_RTW), lc + LC_CNT, dense, kp, (l == DEPTH - 1 && kp == npass - 1) ? 1 : 0, (float*)(a.ws + WS_PART)};
              pg8::gemm_phase<EpiDown, pg8::MoeOrder, true, false>(lds, g, S, E); }
            if (rem > 0) {
                GRID_BAR();
                { PHASE(); const int* list = (const int*)(a.ws + WS_LIST) + (size_t)kp * 8 * 32768; const float* part = (const float*)(a.ws + WS_PART); const float* rtw = (const float*)(a.ws + WS_RTW);
                  pg8::MoeOrder S; S.nRT = nRT; S.nN = 4; S.nwg = nRT * 4; S.G = G; S.c = 0; S.dense = dense; S.K2 = 0; S.tile_e = lc + LC_TILE; S.cnt = lc + LC_CNT; S.list = list; S.KT = FF / 64; S.nfull = (S.nwg / G) * G; S.nsplit = 7;
                  for (int w = blockIdx.x * 8 + wave; w < rem * 256; w += G * 8) { const int ui = w >> 8, r = w & 255; pg8::Unit u; S.decode(S.nfull + ui, u);
                      const int idx = u.lt * 256 + r; int tok = idx; float wgt = 1.f; bool ok = true;
                      if (!dense) { ok = idx < lc[LC_CNT + u.e]; tok = ok ? list[u.e * 32768 + idx] : 0; wgt = ok ? rtw[tok * 2 + kp] : 0.f; }
                      if (ok) { f32x4 sum = (f32x4){0.f, 0.f, 0.f, 0.f};
#pragma unroll
                          for (int sp = 0; sp < 7; ++sp) sum += *(const f32x4*)(part + (size_t)(ui * 7 + sp) * 65536 + r * 256 + 4 * lane);
                          const int col = u.pl * 256 + 4 * lane; const int bb = tok >> 13; const f32x4 gv = *(const f32x4*)(modl + bb * 6144 + 5120 + col);
                          f16* hp = h + (size_t)tok * D + col; const u32x2 t = *(const u32x2*)hp; const f32x4 o = h4(t.x, t.y) + (gv * wgt) * sum;
                          if (l == DEPTH - 1 && kp == npass - 1) *(f32x4*)(a.out + (size_t)tok * D + col) = o; else { u32x2 wv; wv.x = pkh(o.x, o.y); wv.y = pkh(o.z, o.w); *(u32x2*)hp = wv; } } } }
            }
            GRID_BAR();
        }
    }
}

extern "C" void kernel_launch(void* const* d_in, const int* in_sizes, int n_in, void* d_out, int out_size, void* d_ws, size_t ws_size, hipStream_t stream) {
    static int grid = 0;
    if (grid == 0) {
        if (n_in != 34 || in_sizes[0] != M * D || out_size != M * D || ws_size < WS_END) { fprintf(stderr, "kernel_launch: unexpected shapes: n_in %d in0 %d out %d ws %zu (need %zu)\n", n_in, n_in > 0 ? in_sizes[0] : -1, out_size, ws_size, (size_t)WS_END); grid = -1; return; }
        int dev = 0, cus = 0, per_cu = 0;
        if (hipGetDevice(&dev) != hipSuccess || hipDeviceGetAttribute(&cus, hipDeviceAttributeMultiprocessorCount, dev) != hipSuccess) { grid = -1; return; }
        if (hipFuncSetAttribute((const void*)fwd_kernel, hipFuncAttributeMaxDynamicSharedMemorySize, LDS_BYTES) != hipSuccess) { fprintf(stderr, "kernel_launch: hipFuncSetAttribute failed\n"); grid = -1; return; }
        if (hipOccupancyMaxActiveBlocksPerMultiprocessor(&per_cu, (const void*)fwd_kernel, 512, LDS_BYTES) != hipSuccess || per_cu < 1) { fprintf(stderr, "kernel_launch: occupancy query says %d blocks per CU\n", per_cu); (void)hipGetLastError(); grid = -1; return; }
        grid = cus;
    }
    if (grid < 0) return;
    if (hipMemsetAsync((char*)d_ws + WS_CTL, 0, CTL_ZERO_BYTES, stream) != hipSuccess) return;
    Args a{};
    for (int i = 0; i < 34; ++i) a.in[i] = d_in[i];
    a.out = (float*)d_out; a.ws = (unsigned char*)d_ws;
    hipLaunchKernelGGL(fwd_kernel, dim3(grid), dim3(512), LDS_BYTES, stream, a);
}
```
